# Optimizing an MI355X kernel written in HIP

```python
import math
import jax, jax.numpy as jnp
from jax import lax
import numpy as np

D_MODEL = 1024
BATCH = 8
SEQ = 2048
DEPTH = 4
DEC_BATCH = 128
DEC_SEQ = 1
PAST_LEN = 16384
PAGE_SIZE = 128

N_MIXERS = 2
N_A_LAYERS = (DEPTH + 1) // 2
N_B_LAYERS = DEPTH // 2
DK_A = 128
H_A = D_MODEL // DK_A
DV_A = D_MODEL // H_A
CHUNK_A = 32
CHUNK_B = 128
D_INNER_B = D_MODEL
G_B = 8
DG_B = D_INNER_B // G_B
D_FF = -(-(8 * D_MODEL) // (3 * 256)) * 256
ALPHA = (2 * DEPTH) ** 0.25
BETA = (8 * DEPTH) ** -0.25
LN_EPS = 1e-5
RMS_EPS = 1e-6

kernel_name = "hgrn2_chunkmlp_hybrid_step"


def layer_norm(x, g, b):
    xf = x.astype(jnp.float32)
    mu = jnp.mean(xf, axis=-1, keepdims=True)
    var = jnp.mean(jnp.square(xf - mu), axis=-1, keepdims=True)
    return ((xf - mu) * lax.rsqrt(var + LN_EPS) * g + b).astype(x.dtype)


def rms_norm(x, g):
    xf = x.astype(jnp.float32)
    return xf * lax.rsqrt(jnp.mean(jnp.square(xf), axis=-1, keepdims=True) + RMS_EPS) * g


def hgrn2_recurrence(q, k, v, logf, s0):
    b, L, h, dk = q.shape
    dv = v.shape[-1]
    c = math.gcd(L, CHUNK_A)
    n = L // c

    def to_chunks(a):
        return a.reshape(b, n, c, h, a.shape[-1]).transpose(1, 0, 3, 2, 4)

    causal = jnp.tril(jnp.ones((c, c), dtype=bool))[:, :, None]

    def step(s, blk):
        qb, kb, vb, gb = blk
        g = jnp.cumsum(gb, axis=2)
        o_inter = jnp.einsum("bhtk,bhkv->bhtv", qb * jnp.exp(g), s)
        diff = g[:, :, :, None, :] - g[:, :, None, :, :]
        decay = jnp.exp(jnp.where(causal, diff, -jnp.inf))
        a = jnp.einsum("bhtk,bhsk,bhtsk->bhts", qb, kb, decay)
        o_intra = jnp.einsum("bhts,bhsv->bhtv", a, vb)
        g_end = g[:, :, -1:, :]
        s_new = jnp.exp(g_end[:, :, 0, :, None]) * s + jnp.einsum(
            "bhsk,bhsv->bhkv", kb * jnp.exp(g_end - g), vb)
        return s_new, o_inter + o_intra

    s_fin, o = lax.scan(step, s0, (to_chunks(q), to_chunks(k), to_chunks(v), to_chunks(logf)))
    o = o.transpose(1, 0, 3, 2, 4).reshape(b, L, h, dv)
    return o, s_fin


def hgrn2_mixer(x, lower_bound, w_in, norm_g, w_out, s0):
    b, L, _ = x.shape
    dq = H_A * DK_A
    proj = (x @ w_in).astype(jnp.float32)
    q_raw, f_raw, i_raw, g_raw = jnp.split(proj, [dq, 2 * dq, 2 * dq + H_A * DV_A], axis=-1)
    q = jax.nn.silu(q_raw).reshape(b, L, H_A, DK_A) * (DK_A ** -0.5)
    f = lower_bound + (1.0 - lower_bound) * jax.nn.sigmoid(f_raw)
    k = (1.0 - f).reshape(b, L, H_A, DK_A)
    logf = jnp.log(f).reshape(b, L, H_A, DK_A)
    v = i_raw.reshape(b, L, H_A, DV_A)
    o, s_fin = hgrn2_recurrence(q, k, v, logf, s0.astype(jnp.float32))
    o = rms_norm(o, norm_g) * jax.nn.silu(g_raw).reshape(b, L, H_A, DV_A)
    y = o.reshape(b, L, H_A * DV_A).astype(x.dtype) @ w_out
    return y, s_fin


def chunk_mlp(x, w_in, ln_g, ln_b, w_s, b_s, w_out):
    b, L, _ = x.shape
    hdn = jax.nn.gelu(x @ w_in, approximate=False)
    u, v = jnp.split(hdn, 2, axis=-1)
    v = layer_norm(v, ln_g, ln_b)
    c = min(L, CHUNK_B)
    n = L // c
    w = jnp.tril(w_s[:, :c, :c])
    bias = b_s[:, :c].T[None, None, :, :, None]
    mixed = jnp.einsum("gts,bnsgd->bntgd", w, v.reshape(b, n, c, G_B, DG_B)) + bias
    y = (u * mixed.reshape(b, L, D_INNER_B)).astype(x.dtype) @ w_out
    return y, v[:, L - c:]


def swiglu_ffn(x, w_in, w_out):
    gate, up = jnp.split(x @ w_in, 2, axis=-1)
    return (jax.nn.silu(gate) * up) @ w_out


def setup_inputs(seed: int = 0) -> dict:
    key = jax.random.key(seed)
    ks = jax.random.split(key, 19)
    f32 = jnp.float32

    def nrm(k, shape, scale):
        return jax.random.normal(k, shape, f32) * scale

    return {
        "x_prompt": nrm(ks[0], (BATCH, SEQ, D_MODEL), 1.0),
        "x_sample": nrm(ks[1], (DEC_BATCH, DEC_SEQ, D_MODEL), 1.0),
        "state_hgrn": nrm(ks[2], (N_A_LAYERS, DEC_BATCH, H_A, DK_A, DV_A), 0.5),
        "ln_mix_g": 1.0 + nrm(ks[3], (DEPTH, D_MODEL), 0.05),
        "ln_mix_b": nrm(ks[4], (DEPTH, D_MODEL), 0.05),
        "ln_ffn_g": 1.0 + nrm(ks[5], (DEPTH, D_MODEL), 0.05),
        "ln_ffn_b": nrm(ks[6], (DEPTH, D_MODEL), 0.05),
        "a_lb_raw": nrm(ks[7], (DEPTH, H_A * DK_A), 0.5),
        "a_w_in": nrm(ks[8], (N_A_LAYERS, D_MODEL, 2 * H_A * DK_A + 2 * H_A * DV_A), D_MODEL ** -0.5),
        "a_norm_g": 1.0 + nrm(ks[9], (N_A_LAYERS, DV_A), 0.05),
        "a_w_out": nrm(ks[10], (N_A_LAYERS, H_A * DV_A, D_MODEL), BETA * (H_A * DV_A) ** -0.5),
        "b_w_in": nrm(ks[11], (N_B_LAYERS, D_MODEL, 2 * D_INNER_B), D_MODEL ** -0.5),
        "b_ln_g": 1.0 + nrm(ks[12], (N_B_LAYERS, D_INNER_B), 0.05),
        "b_ln_b": nrm(ks[13], (N_B_LAYERS, D_INNER_B), 0.05),
        "b_w_s": nrm(ks[14], (N_B_LAYERS, G_B, CHUNK_B, CHUNK_B), CHUNK_B ** -0.5),
        "b_bias_s": 1.0 + nrm(ks[15], (N_B_LAYERS, G_B, CHUNK_B), 0.1),
        "b_w_out": nrm(ks[16], (N_B_LAYERS, D_INNER_B, D_MODEL), BETA * D_INNER_B ** -0.5),
        "ffn_w_in": nrm(ks[17], (DEPTH, D_MODEL, 2 * D_FF), D_MODEL ** -0.5),
        "ffn_w_out": nrm(ks[18], (DEPTH, D_FF, D_MODEL), BETA * D_FF ** -0.5),
    }


def reference(x_prompt, x_sample, state_hgrn, ln_mix_g, ln_mix_b, ln_ffn_g, ln_ffn_b,
              a_lb_raw, a_w_in, a_norm_g, a_w_out, b_w_in, b_ln_g, b_ln_b, b_w_s, b_bias_s,
              b_w_out, ffn_w_in, ffn_w_out):
    p = jax.nn.softmax(a_lb_raw.astype(jnp.float32), axis=0)
    lower_bounds = jnp.cumsum(p, axis=0) - p[0]

    def trunk(x, hgrn_init):
        hgrn_out, v_out = [], []
        for layer in range(DEPTH):
            j = layer // N_MIXERS
            if layer % N_MIXERS == 0:
                h, s = hgrn2_mixer(x, lower_bounds[layer], a_w_in[j], a_norm_g[j], a_w_out[j], hgrn_init[j])
                hgrn_out.append(s.astype(state_hgrn.dtype))
            else:
                h, v_rows = chunk_mlp(x, b_w_in[j], b_ln_g[j], b_ln_b[j], b_w_s[j], b_bias_s[j], b_w_out[j])
                v_out.append(v_rows)
            x = layer_norm(ALPHA * x + h, ln_mix_g[layer], ln_mix_b[layer])
            x = layer_norm(ALPHA * x + swiglu_ffn(x, ffn_w_in[layer], ffn_w_out[layer]),
                           ln_ffn_g[layer], ln_ffn_b[layer])
        return x, jnp.stack(hgrn_out), jnp.stack(v_out)

    prompt_init = jnp.zeros((N_A_LAYERS, x_prompt.shape[0], H_A, DK_A, DV_A), jnp.float32)
    y_prompt, hgrn_state_prompt, chunk_v_prompt = trunk(x_prompt, prompt_init)
    y_sample, hgrn_state_sample, chunk_v_sample = trunk(x_sample, state_hgrn)
    return (y_prompt, y_sample, hgrn_state_prompt, hgrn_state_sample, chunk_v_prompt, chunk_v_sample)
```

```cpp
#include <hip/hip_runtime.h>
#include <hip/hip_cooperative_groups.h>
#include <cstdio>
namespace cg = cooperative_groups;

typedef unsigned short bf16_t;
typedef short bf16x8 __attribute__((ext_vector_type(8)));
typedef float f32x4 __attribute__((ext_vector_type(4)));
typedef float f32x2 __attribute__((ext_vector_type(2)));

constexpr int P = 16384, SR = 128, MT = P + SR, D = 1024, DFF = 2816;
constexpr float ALPHA = 1.681792830507429f;
constexpr float LN_EPS = 1e-5f, RMS_EPS = 1e-6f;
constexpr int LDS_BYTES = 131072 + 64 + 2048;

constexpr size_t al256(size_t x) { return (x + 255) & ~(size_t)255; }
constexpr size_t SZ_ACT = (size_t)MT * D * 2;
constexpr size_t OFF_WT_A_IN = 0;
constexpr size_t OFF_WT_A_OUT = OFF_WT_A_IN + (size_t)2 * 4096 * 1024 * 2;
constexpr size_t OFF_WT_B_IN = OFF_WT_A_OUT + (size_t)2 * 1024 * 1024 * 2;
constexpr size_t OFF_WT_B_OUT = OFF_WT_B_IN + (size_t)2 * 2048 * 1024 * 2;
constexpr size_t OFF_WT_F_IN = OFF_WT_B_OUT + (size_t)2 * 1024 * 1024 * 2;
constexpr size_t OFF_WT_F_OUT = OFF_WT_F_IN + (size_t)4 * 5632 * 1024 * 2;
constexpr size_t OFF_C1_A = OFF_WT_F_OUT + (size_t)4 * 1024 * 2816 * 2;
constexpr size_t OFF_C2_A = OFF_C1_A + 2 * 4096 * 4;
constexpr size_t OFF_C1_B = OFF_C2_A + 2 * 4096 * 4;
constexpr size_t OFF_C2_B = OFF_C1_B + 2 * 2048 * 4;
constexpr size_t OFF_C1_F = OFF_C2_B + 2 * 2048 * 4;
constexpr size_t OFF_C2_F = OFF_C1_F + 4 * 5632 * 4;
constexpr size_t OFF_LB = OFF_C2_F + 4 * 5632 * 4;
constexpr size_t OFF_ONES = OFF_LB + 2 * 1024 * 4;
constexpr size_t OFF_X0 = al256(OFF_ONES + 2 * 1024 * 4);
constexpr size_t OFF_ZMIX = OFF_X0 + SZ_ACT;
constexpr size_t OFF_ZFFN = OFF_ZMIX + SZ_ACT;
constexpr size_t SZ_ST = (size_t)MT * 16 * 8;
constexpr size_t OFF_STM = OFF_ZFFN + SZ_ACT;
constexpr size_t OFF_STF = OFF_STM + SZ_ST;
constexpr size_t OFF_STV = OFF_STF + SZ_ST;
constexpr size_t OFF_Q = OFF_STV + SZ_ST;
constexpr size_t OFF_K = OFF_Q + SZ_ACT;
constexpr size_t OFF_V = OFF_K + SZ_ACT;
constexpr size_t OFF_G = OFF_V + SZ_ACT;
constexpr size_t OFF_O = OFF_G + SZ_ACT;
constexpr size_t OFF_H = OFF_O + SZ_ACT;
constexpr size_t OFF_BAR = al256(OFF_H + (size_t)MT * DFF * 2);
constexpr size_t OFF_AM = OFF_BAR + 16384;
constexpr size_t WS_END = OFF_AM + (size_t)2048 * 4096 * 2;

constexpr size_t OUT_YP = 0, OUT_YS = (size_t)P * D, OUT_HSP = OUT_YS + (size_t)SR * D, OUT_HSS = OUT_HSP + (size_t)2 * 8 * 8 * 16384,
                 OUT_CVP = OUT_HSS + (size_t)2 * 128 * 8 * 16384, OUT_CVS = OUT_CVP + (size_t)2 * 8 * 128 * 1024;

struct Params { const float* in[19]; float* out; unsigned char* ws; };

__device__ __forceinline__ float bf2f(unsigned b) { return __uint_as_float(b << 16); }
__device__ __forceinline__ unsigned short f2bf(float f) { unsigned u = __float_as_uint(f); u += 0x7FFFu + ((u >> 16) & 1u); return (unsigned short)(u >> 16); }
__device__ __forceinline__ unsigned cvt_pk_bf16(float lo, float hi) { unsigned r; asm volatile("v_cvt_pk_bf16_f32 %0, %1, %2" : "=v"(r) : "v"(lo), "v"(hi)); return r; }
__device__ __forceinline__ f32x4 ld_bf4(const bf16_t* p) { const uint2 w = *(const uint2*)p; return (f32x4){bf2f(w.x & 0xffffu), bf2f(w.x >> 16), bf2f(w.y & 0xffffu), bf2f(w.y >> 16)}; }
__device__ __forceinline__ void st_bf4(bf16_t* p, f32x4 v) { uint2 w; w.x = cvt_pk_bf16(v[0], v[1]); w.y = cvt_pk_bf16(v[2], v[3]); *(uint2*)p = w; }
typedef unsigned v4u __attribute__((ext_vector_type(4)));
__device__ __forceinline__ __amdgpu_buffer_rsrc_t wt_rsrc(void* base) { return __builtin_amdgcn_make_buffer_rsrc(base, 0, 0x7ffffff0, 0x00020000); }
__device__ __forceinline__ void st16_wt(__amdgpu_buffer_rsrc_t r, unsigned byteoff, v4u w) { __builtin_amdgcn_raw_buffer_store_b128(w, r, byteoff, 0, 16); }
template <int CTRL> __device__ __forceinline__ float dppf(float x) { return __builtin_bit_cast(float, __builtin_amdgcn_mov_dpp(__builtin_bit_cast(int, x), CTRL, 0xf, 0xf, true)); }

namespace pg8 {
#define PG8_LAS __attribute__((address_space(3)))
constexpr int BM = 256, BK = 64, HALF = 128, HTB = HALF * BK * 2, STAGE_BYTES = 8 * HTB, NXCD = 8, WGM = 8;
__host__ __device__ __forceinline__ int lds_byte(int r, int c) { const int st = (r >> 4) * 2 + (c >> 5), rr = r & 15, cc = c & 31, ob = rr * 64 + cc * 2; return st * 1024 + (ob ^ (((ob >> 9) & 1) << 5)); }
__host__ __device__ __forceinline__ void stage_rc(int b, int& R, int& C) { const int st = b / 1024, sb = b % 1024, swz = sb ^ (((sb >> 9) & 1) << 5); R = (st >> 1) * 16 + swz / 64; C = (st & 1) * 32 + (swz % 64) / 2; }
struct Unit { int pm, pn; };
struct Gemm { const bf16_t* A; const bf16_t* Bt; int M, N, K; };
struct StaticOrder {
    int nM, nN, nwg, G, c;
    __host__ __device__ void init(int M, int N, int G_, int c_) { nM = M / BM; nN = N / BM; nwg = nM * nN; G = G_; c = c_; }
    __host__ __device__ bool next(int i, Unit& u) const {
        const int L = i * G + c; if (L >= nwg) return false;
        const int xcd = L & 7, off = L >> 3;
        u.pm = xcd * 8 + (off & 7); u.pn = off >> 3; return true;
    }
    __device__ __forceinline__ void a_ready(const Unit&) const {}
    __device__ __forceinline__ void done(const Unit&) const {}
};
template <class Epi, class Sched>
__device__ __forceinline__ void gemm_phase(PG8_LAS unsigned char* lds, const Gemm g, const Sched& S, const Epi& E) {
    int tid_ = threadIdx.x; asm volatile("" : "+v"(tid_));
    const int tid = tid_, wid = __builtin_amdgcn_readfirstlane(tid >> 6), lane = tid & 63, wr = wid >> 2, wc = wid & 3, fr = lane & 15, fq = lane >> 4;
    const int K = g.K, nt = K / BK;
    unsigned voffA[2];
#pragma unroll
    for (int i = 0; i < 2; ++i) { int R, C; stage_rc(tid * 16 + i * 8192, R, C); voffA[i] = (unsigned)(R * K + C) * 2u; }
    const size_t kstep = (size_t)(BK * 2);
    const size_t hstep = (size_t)HALF * K * 2;
    const size_t tstep = 2 * hstep;
    const unsigned ldsw = (unsigned)wid * 1024u;
    const int aoff = lds_byte(wr * 64 + fr, fq * 8), boff = lds_byte(wc * 32 + fr, fq * 8);
#define PG8_SA(b, h) (((b) * 2 + (h)) * HTB)
#define PG8_SB(b, h) ((4 + (b) * 2 + (h)) * HTB)
#define PG8_STAGE(bufoff, gbase, voff) do { _Pragma("unroll") for (int _i = 0; _i < 2; ++_i) \
        __builtin_amdgcn_global_load_lds((const unsigned*)((const char*)(gbase) + (voff)[_i]), (PG8_LAS unsigned*)(lds + (bufoff) + ldsw + _i * 8192), 16, 0, 0); } while (0)
#define PG8_LDA(dst, b, h) do { _Pragma("unroll") for (int m = 0; m < 4; ++m) _Pragma("unroll") for (int k = 0; k < 2; ++k) dst[m][k] = *(const PG8_LAS bf16x8*)(lds + PG8_SA(b, h) + aoff + m * 2048 + k * 1024); } while (0)
#define PG8_LDB(dst, b, h) do { _Pragma("unroll") for (int n = 0; n < 2; ++n) _Pragma("unroll") for (int k = 0; k < 2; ++k) dst[n][k] = *(const PG8_LAS bf16x8*)(lds + PG8_SB(b, h) + boff + n * 2048 + k * 1024); } while (0)
#define PG8_MMA(ai, bj, At, Bt) do { __builtin_amdgcn_s_setprio(1); _Pragma("unroll") for (int m = 0; m < 4; ++m) _Pragma("unroll") for (int n = 0; n < 2; ++n) _Pragma("unroll") for (int k = 0; k < 2; ++k) \
        acc[ai][bj][m][n] = __builtin_amdgcn_mfma_f32_16x16x32_bf16(Bt[n][k], At[m][k], acc[ai][bj][m][n], 0, 0, 0); __builtin_amdgcn_s_setprio(0); } while (0)
#define PG8_WAIT_V(n) asm volatile("s_waitcnt vmcnt(" #n ")" ::: "memory")
#define PG8_WAIT_L(n) asm volatile("s_waitcnt lgkmcnt(" #n ")" ::: "memory")
#define PG8_BAR __builtin_amdgcn_s_barrier()
#define PG8_SCHED __builtin_amdgcn_sched_barrier(0)
    Unit cur, nxt; int ui = 0;
    if (!S.next(0, cur)) return;
    f32x4 acc[2][2][4][2];
#pragma unroll
    for (int a = 0; a < 2; ++a)
#pragma unroll
        for (int b = 0; b < 2; ++b)
#pragma unroll
            for (int m = 0; m < 4; ++m)
#pragma unroll
                for (int n = 0; n < 2; ++n) acc[a][b][m][n] = (f32x4){0.f, 0.f, 0.f, 0.f};
    bf16x8 At[4][2], B0[2][2], B1[2][2];
    const char* cA = (const char*)g.A + (size_t)cur.pm * tstep; const char* cB = (const char*)g.Bt + (size_t)cur.pn * tstep;
    S.a_ready(cur);
    PG8_STAGE(PG8_SB(0, 0), cB, voffA); PG8_STAGE(PG8_SA(0, 0), cA, voffA); PG8_STAGE(PG8_SB(0, 1), cB + hstep, voffA); PG8_STAGE(PG8_SA(0, 1), cA + hstep, voffA);
    if (wr == 1) PG8_BAR;
    PG8_WAIT_V(4); PG8_BAR;
    PG8_STAGE(PG8_SB(1, 0), cB + kstep, voffA); PG8_STAGE(PG8_SA(1, 0), cA + kstep, voffA); PG8_STAGE(PG8_SB(1, 1), cB + hstep + kstep, voffA);
    PG8_WAIT_V(6); PG8_BAR;
    for (;;) {
        const bool has_next = S.next(ui + 1, nxt);
        const char* nA = has_next ? (const char*)g.A + (size_t)nxt.pm * tstep : cA; const char* nB = has_next ? (const char*)g.Bt + (size_t)nxt.pn * tstep : cB;
        for (int t = 0; t < nt; t += 2) {
            const bool last = (t == nt - 2);
            const char* a1 = cA + (size_t)(t + 1) * kstep;
            const char* a2 = last ? nA : cA + (size_t)(t + 2) * kstep; const char* b2 = last ? nB : cB + (size_t)(t + 2) * kstep;
            const char* a3 = a2 + kstep; const char* b3 = b2 + kstep;
            if (last && has_next) S.a_ready(nxt);
            PG8_LDB(B0, 0, 0); PG8_SCHED; PG8_LDA(At, 0, 0); PG8_STAGE(PG8_SA(1, 1), a1 + hstep, voffA);
            PG8_WAIT_L(8); PG8_BAR; PG8_WAIT_L(0); PG8_MMA(0, 0, At, B0); PG8_BAR; PG8_SCHED;
            PG8_LDB(B1, 0, 1); PG8_STAGE(PG8_SB(0, 0), b2, voffA);
            PG8_BAR; PG8_WAIT_L(0); PG8_MMA(0, 1, At, B1); PG8_BAR;
            PG8_LDA(At, 0, 1); PG8_STAGE(PG8_SA(0, 0), a2, voffA);
            PG8_BAR; PG8_WAIT_L(0); PG8_MMA(1, 0, At, B0); PG8_BAR; PG8_SCHED;
            PG8_STAGE(PG8_SB(0, 1), b2 + hstep, voffA);
            PG8_WAIT_V(6); PG8_BAR; PG8_MMA(1, 1, At, B1); PG8_BAR;
            PG8_LDB(B0, 1, 0); PG8_SCHED; PG8_LDA(At, 1, 0); PG8_STAGE(PG8_SA(0, 1), a2 + hstep, voffA);
            PG8_WAIT_L(8); PG8_BAR; PG8_WAIT_L(0); PG8_MMA(0, 0, At, B0); PG8_BAR; PG8_SCHED;
            PG8_LDB(B1, 1, 1); PG8_STAGE(PG8_SB(1, 0), b3, voffA);
            PG8_BAR; PG8_WAIT_L(0); PG8_MMA(0, 1, At, B1); PG8_BAR;
            PG8_LDA(At, 1, 1); PG8_STAGE(PG8_SA(1, 0), a3, voffA);
            PG8_BAR; PG8_WAIT_L(0); PG8_MMA(1, 0, At, B0); PG8_BAR; PG8_SCHED;
            PG8_STAGE(PG8_SB(1, 1), b3 + hstep, voffA);
            PG8_WAIT_V(6); PG8_BAR; PG8_MMA(1, 1, At, B1); PG8_BAR;
        }
        E(acc, cur, wr, wc, fr, fq); S.done(cur);
        if (!has_next) break;
#pragma unroll
        for (int a = 0; a < 2; ++a)
#pragma unroll
            for (int b = 0; b < 2; ++b)
#pragma unroll
                for (int m = 0; m < 4; ++m)
#pragma unroll
                    for (int n = 0; n < 2; ++n) acc[a][b][m][n] = (f32x4){0.f, 0.f, 0.f, 0.f};
        cur = nxt; cA = nA; cB = nB; ++ui;
    }
    PG8_WAIT_V(0);
    if (wr == 0) PG8_BAR;
    PG8_BAR;
#undef PG8_SA
#undef PG8_SB
#undef PG8_STAGE
#undef PG8_LDA
#undef PG8_LDB
#undef PG8_MMA
#undef PG8_WAIT_V
#undef PG8_WAIT_L
#undef PG8_BAR
#undef PG8_SCHED
}
}

struct Epi {
    const float2* stat;
    const float* a;
    const float* b;
    bf16_t* o;
    float2* opart;
    const void* x;
};
__device__ __forceinline__ f32x4 sigm4(f32x4 x) { f32x4 r; for (int i = 0; i < 4; ++i) r[i] = __builtin_amdgcn_rcpf(1.0f + __expf(-x[i])); return r; }
__device__ __forceinline__ f32x4 gelu4(f32x4 v) {
    f32x4 o;
#pragma unroll
    for (int i = 0; i < 4; ++i) {
        const float x = v[i], av = fabsf(x), t = __builtin_amdgcn_rcpf(av * 0.2316418882f + 1.0f);
        float q = t * 0.5307027145f + (-0.7265760135f); q = q * t + 0.7107068705f; q = q * t + (-0.142248368f); q = q * t + 0.127414796f; q = q * t;
        const float e = __builtin_amdgcn_exp2f(x * x * (-0.72134752044f));
        const float m = x * (q * e);
        o[i] = x < 0.f ? m : x - m;
    }
    return o;
}
template <int KIND> __device__ __forceinline__ f32x4 epi_val(int col, f32x4 a, float mu, float rstd, f32x4 va, f32x4 vb, f32x4 vx) {
    if constexpr (KIND == 0) {
        const f32x4 val = (a - va * mu) * rstd + vb;
        const int seg = col >> 10;
        if (seg == 0) return val * sigm4(val) * 0.08838834764831845f;
        else if (seg == 1) return (1.0f - vx) * sigm4(-val);
        else if (seg == 2) return val;
        else return val * sigm4(val);
    } else if constexpr (KIND == 1) {
        return ((vx - mu) * rstd * va + vb) * ALPHA + a;
    } else {
        return gelu4((a - va * mu) * rstd + vb);
    }
}
template <int KIND> __device__ __forceinline__ bf16_t* epi_ptr(const Epi& e, int row, int col) {
    if constexpr (KIND == 1) return e.o + (size_t)row * 1024 + col;
    else return e.o + (size_t)(col >> 10) * ((size_t)MT * 1024) + (size_t)row * 1024 + (col & 1023);
}
template <int KIND> __device__ __forceinline__ unsigned epi_off(int row, int col) {
    if constexpr (KIND == 1) return (unsigned)(row * 1024 + col) * 2u;
    else return ((unsigned)(col >> 10) * (unsigned)(MT * 1024) + (unsigned)(row * 1024 + (col & 1023))) * 2u;
}
template <int KIND> __device__ __forceinline__ f32x4 epi_quad(const Epi& e, int row, int col, f32x4 a, float mu, float rstd, f32x4 va, f32x4 vb, f32x4 vx) {
    const f32x4 y = epi_val<KIND>(col, a, mu, rstd, va, vb, vx); st_bf4(epi_ptr<KIND>(e, row, col), y); return y;
}
__device__ __forceinline__ f32x4 epi_val2(f32x4 ga, f32x4 ua, float mu, float rstd, f32x4 c1g, f32x4 c2g, f32x4 c1u, f32x4 c2u) {
    const f32x4 g = (ga - c1g * mu) * rstd + c2g;
    const f32x4 u = (ua - c1u * mu) * rstd + c2u;
    return g * sigm4(g) * u;
}
__device__ __forceinline__ void epi_quad2(const Epi& e, int row, int c, f32x4 ga, f32x4 ua, float mu, float rstd, f32x4 c1g, f32x4 c2g, f32x4 c1u, f32x4 c2u) {
    st_bf4(e.o + (size_t)row * DFF + c, epi_val2(ga, ua, mu, rstd, c1g, c2g, c1u, c2u));
}
__device__ __forceinline__ void st_bf8_wt(__amdgpu_buffer_rsrc_t r, unsigned byteoff, f32x4 y0, f32x4 y1) { v4u w; w.x = cvt_pk_bf16(y0[0], y0[1]); w.y = cvt_pk_bf16(y0[2], y0[3]); w.z = cvt_pk_bf16(y1[0], y1[1]); w.w = cvt_pk_bf16(y1[2], y1[3]); st16_wt(r, byteoff, w); }
__device__ __forceinline__ void stat_finish(float s, float q, float& mu, float& rstd) {
    mu = s * (1.0f / 1024.0f); const float var = fmaxf(q * (1.0f / 1024.0f) - mu * mu, 0.f); rstd = rsqrtf(var + LN_EPS);
}
__device__ __forceinline__ void rowstat_full(const float2* part, int row, float& mu, float& rstd) {
    const float4* pp = (const float4*)(part + (size_t)row * 16); float s = 0.f, q = 0.f;
#pragma unroll
    for (int i = 0; i < 8; ++i) { const float4 a = pp[i]; s += a.x + a.z; q += a.y + a.w; }
    stat_finish(s, q, mu, rstd);
}

constexpr int TAB_OFF = 131072 + 64;
template <int KIND> struct BigEpi {
    Epi e;
    __device__ __forceinline__ void operator()(const f32x4 (&acc)[2][2][4][2], const pg8::Unit& u, int wr, int wc, int fr, int fq) const {
        extern __shared__ __attribute__((aligned(16))) unsigned char shm_[];
        const float2* tab = (const float2*)(shm_ + TAB_OFF);
        const __amdgpu_buffer_rsrc_t orsrc = wt_rsrc(e.o);
        int pc0_ = u.pn * 256 + wc * 32 + fq * 8; asm volatile("" : "+v"(pc0_));
        const int pc0 = pc0_;
        f32x4 va[2][2], vb[2][2], vl[2][2];
#pragma unroll
        for (int bj = 0; bj < 2; ++bj)
#pragma unroll
            for (int n = 0; n < 2; ++n) {
                va[bj][n] = *(const f32x4*)(e.a + pc0 + bj * 128 + n * 4); vb[bj][n] = *(const f32x4*)(e.b + pc0 + bj * 128 + n * 4);
                if (KIND == 0 && (u.pn >> 2) == 1) vl[bj][n] = *(const f32x4*)((const float*)e.x + ((pc0 + bj * 128 + n * 4) & 1023)); else vl[bj][n] = (f32x4){0.f, 0.f, 0.f, 0.f};
            }
        constexpr int GR = (KIND == 3) ? 1 : 2;
#pragma unroll
        for (int g4 = 0; g4 < 8 / GR; ++g4) {
            const int ai = (g4 * GR) >> 2, m0 = (g4 * GR) & 3;
            int rowl_ = ai * 128 + wr * 64 + m0 * 16 + fr; asm volatile("" : "+v"(rowl_));
            const int rowl = rowl_, rowb = u.pm * 256 + rowl;
            uint4 zz[GR][2];
            if constexpr (KIND == 1) {
#pragma unroll
                for (int mm = 0; mm < GR; ++mm)
#pragma unroll
                    for (int bj = 0; bj < 2; ++bj) zz[mm][bj] = *(const uint4*)((const bf16_t*)e.x + (size_t)(rowb + mm * 16) * 1024 + pc0 + bj * 128);
                asm volatile("" ::: "memory");
            }
#pragma unroll
            for (int mm = 0; mm < GR; ++mm) {
                const int row = rowb + mm * 16, m = m0 + mm;
                float mu = 0.f, rstd = 1.f;
                if (e.stat) { const float2 ms = tab[rowl + mm * 16]; mu = ms.x; rstd = ms.y; }
                float s = 0.f, q = 0.f;
                if constexpr (KIND == 2) {
                    const f32x4 y0 = epi_val2(acc[ai][0][m][0], acc[ai][1][m][0], mu, rstd, va[0][0], vb[0][0], va[1][0], vb[1][0]);
                    const f32x4 y1 = epi_val2(acc[ai][0][m][1], acc[ai][1][m][1], mu, rstd, va[0][1], vb[0][1], va[1][1], vb[1][1]);
                    st_bf8_wt(orsrc, (unsigned)(row * DFF + u.pn * 128 + wc * 32 + fq * 8) * 2u, y0, y1);
                } else {
#pragma unroll
                    for (int bj = 0; bj < 2; ++bj) {
                        f32x4 x0 = vl[bj][0], x1 = vl[bj][1];
                        if constexpr (KIND == 1) { const uint4 w = zz[mm][bj]; x0 = (f32x4){bf2f(w.x & 0xffffu), bf2f(w.x >> 16), bf2f(w.y & 0xffffu), bf2f(w.y >> 16)}; x1 = (f32x4){bf2f(w.z & 0xffffu), bf2f(w.z >> 16), bf2f(w.w & 0xffffu), bf2f(w.w >> 16)}; }
                        const int col = pc0 + bj * 128;
                        v4u w;
                        { const f32x4 r0 = epi_val<KIND>(col, acc[ai][bj][m][0], mu, rstd, va[bj][0], vb[bj][0], x0);
                          w.x = cvt_pk_bf16(r0[0], r0[1]); w.y = cvt_pk_bf16(r0[2], r0[3]);
                          s += (r0[0] + r0[1]) + (r0[2] + r0[3]); q += (r0[0] * r0[0] + r0[1] * r0[1]) + (r0[2] * r0[2] + r0[3] * r0[3]); }
                        if constexpr (KIND == 3) __builtin_amdgcn_sched_barrier(0);
                        { const f32x4 r1 = epi_val<KIND>(col, acc[ai][bj][m][1], mu, rstd, va[bj][1], vb[bj][1], x1);
                          w.z = cvt_pk_bf16(r1[0], r1[1]); w.w = cvt_pk_bf16(r1[2], r1[3]);
                          s += (r1[0] + r1[1]) + (r1[2] + r1[3]); q += (r1[0] * r1[0] + r1[1] * r1[1]) + (r1[2] * r1[2] + r1[3] * r1[3]); }
                        st16_wt(orsrc, epi_off<KIND>(row, col), w);
                        if constexpr (KIND == 3) __builtin_amdgcn_sched_barrier(0);
                    }
                }
                if constexpr (KIND == 1 || KIND == 3) {
                    s += __shfl_xor(s, 16); s += __shfl_xor(s, 32); q += __shfl_xor(q, 16); q += __shfl_xor(q, 32);
                    if (fq == 0 && (KIND == 1 || u.pn >= 4)) e.opart[(size_t)row * 16 + (u.pn & 3) * 4 + wc] = make_float2(s, q);
                }
            }
            asm volatile("" ::: "memory");
        }
    }
};

template <int KIND> __device__ __forceinline__ void small_gemm(unsigned char* shm, const bf16_t* A, const bf16_t* Bt, int N, int K, const Epi& e) {
    float* red = (float*)shm;
    int tid_ = threadIdx.x; asm volatile("" : "+v"(tid_));
    const int tid = tid_, wid = tid >> 6, lane = tid & 63, fr = lane & 15, fq = lane >> 4;
    const int ncu = (KIND == 2) ? (N / 256) * 4 : N / 64, nunits = ncu * 4;
    const int nb = (KIND == 2) ? 128 : (int)gridDim.x, bi = (int)gridDim.x - 1 - (int)blockIdx.x;
    for (int unit = bi; unit < nunits && bi < nb; unit += nb) {
        const int ru = unit & 3, cu = unit >> 2, r0 = ru * 32;
        int b0, b1, lcol;
        if (KIND == 2) { const int cb = cu >> 2, cq = cu & 3; b0 = cb * 256 + cq * 32; b1 = b0 + 128; lcol = cb * 128 + cq * 32; }
        else { b0 = cu * 64; b1 = b0 + 32; lcol = b0; }
        const int kw = K >> 3, kbeg = wid * kw;
        f32x4 acc[2][2][2];
#pragma unroll
        for (int t = 0; t < 2; ++t)
#pragma unroll
            for (int i = 0; i < 2; ++i)
#pragma unroll
                for (int j = 0; j < 2; ++j) acc[t][i][j] = (f32x4){0.f, 0.f, 0.f, 0.f};
        const int rr = tid >> 4, jj = tid & 15, row = P + r0 + rr;
        float4 sp[8];
        if (e.stat) { const float4* pp = (const float4*)(e.stat + (size_t)row * 16);
#pragma unroll
            for (int i = 0; i < 8; ++i) sp[i] = pp[i]; }
        const int ecol = (KIND == 2) ? (((lcol + (jj & 7) * 4) >> 7) * 256 + ((lcol + (jj & 7) * 4) & 127)) : (lcol + (jj >> 3) * 32 + (jj & 7) * 4);
        const f32x4 pva = *(const f32x4*)(e.a + ecol), pvb = *(const f32x4*)(e.b + ecol);
        f32x4 pvx = (f32x4){0.f, 0.f, 0.f, 0.f}, pvy = pvx;
        if constexpr (KIND == 2) { pvx = *(const f32x4*)(e.a + ecol + 128); pvy = *(const f32x4*)(e.b + ecol + 128); }
        if constexpr (KIND == 0) { if ((ecol >> 10) == 1) pvx = *(const f32x4*)((const float*)e.x + (ecol & 1023)); }
        if constexpr (KIND == 1) pvx = ld_bf4((const bf16_t*)e.x + (size_t)row * 1024 + ecol);
        const bf16_t* ap = A + (size_t)(P + r0 + fr) * K + kbeg + 8 * fq;
        const bf16_t* bp0 = Bt + (size_t)(b0 + fr) * K + kbeg + 8 * fq;
        const bf16_t* bp1 = Bt + (size_t)(b1 + fr) * K + kbeg + 8 * fq;
        const size_t r16 = (size_t)16 * K;
#pragma unroll 4
        for (int kk = 0; kk < kw; kk += 32) {
            const bf16x8 a0 = *(const bf16x8*)(ap + kk), a1 = *(const bf16x8*)(ap + r16 + kk);
            const bf16x8 b00 = *(const bf16x8*)(bp0 + kk), b01 = *(const bf16x8*)(bp0 + r16 + kk), b10 = *(const bf16x8*)(bp1 + kk), b11 = *(const bf16x8*)(bp1 + r16 + kk);
            acc[0][0][0] = __builtin_amdgcn_mfma_f32_16x16x32_bf16(b00, a0, acc[0][0][0], 0, 0, 0);
            acc[0][0][1] = __builtin_amdgcn_mfma_f32_16x16x32_bf16(b01, a0, acc[0][0][1], 0, 0, 0);
            acc[0][1][0] = __builtin_amdgcn_mfma_f32_16x16x32_bf16(b00, a1, acc[0][1][0], 0, 0, 0);
            acc[0][1][1] = __builtin_amdgcn_mfma_f32_16x16x32_bf16(b01, a1, acc[0][1][1], 0, 0, 0);
            acc[1][0][0] = __builtin_amdgcn_mfma_f32_16x16x32_bf16(b10, a0, acc[1][0][0], 0, 0, 0);
            acc[1][0][1] = __builtin_amdgcn_mfma_f32_16x16x32_bf16(b11, a0, acc[1][0][1], 0, 0, 0);
            acc[1][1][0] = __builtin_amdgcn_mfma_f32_16x16x32_bf16(b10, a1, acc[1][1][0], 0, 0, 0);
            acc[1][1][1] = __builtin_amdgcn_mfma_f32_16x16x32_bf16(b11, a1, acc[1][1][1], 0, 0, 0);
        }
#pragma unroll
        for (int t = 0; t < 2; ++t)
#pragma unroll
            for (int i = 0; i < 2; ++i)
#pragma unroll
                for (int j = 0; j < 2; ++j) *(f32x4*)(red + ((wid * 2 + t) * 32 + 16 * i + fr) * 32 + 8 * fq + 4 * j) = acc[t][i][j];
        __syncthreads();
        float mu = 0.f, rstd = 1.f;
        if (e.stat) { float s = 0.f, q = 0.f;
#pragma unroll
            for (int i = 0; i < 8; ++i) { s += sp[i].x + sp[i].z; q += sp[i].y + sp[i].w; }
            stat_finish(s, q, mu, rstd); }
        if constexpr (KIND == 2) {
            if (jj < 8) {
                const int c4 = jj * 4; f32x4 ga = (f32x4){0.f, 0.f, 0.f, 0.f}, ua = ga;
#pragma unroll
                for (int w = 0; w < 8; ++w) { ga += *(const f32x4*)(red + ((w * 2 + 0) * 32 + rr) * 32 + c4); ua += *(const f32x4*)(red + ((w * 2 + 1) * 32 + rr) * 32 + c4); }
                epi_quad2(e, row, lcol + c4, ga, ua, mu, rstd, pva, pvb, pvx, pvy);
            }
        } else {
            const int t = jj >> 3, c4 = (jj & 7) * 4; f32x4 v = (f32x4){0.f, 0.f, 0.f, 0.f};
#pragma unroll
            for (int w = 0; w < 8; ++w) v += *(const f32x4*)(red + ((w * 2 + t) * 32 + rr) * 32 + c4);
            const f32x4 r = epi_quad<KIND>(e, row, ecol, v, mu, rstd, pva, pvb, pvx);
            if constexpr (KIND == 1 || KIND == 3) {
                float s = (r[0] + r[1]) + (r[2] + r[3]), q = (r[0] * r[0] + r[1] * r[1]) + (r[2] * r[2] + r[3] * r[3]);
                s += __shfl_xor(s, 1); s += __shfl_xor(s, 2); s += __shfl_xor(s, 4); s += __shfl_xor(s, 8);
                q += __shfl_xor(q, 1); q += __shfl_xor(q, 2); q += __shfl_xor(q, 4); q += __shfl_xor(q, 8);
                if (jj == 0 && (KIND == 1 || cu >= 16)) e.opart[(size_t)row * 16 + (cu & 15)] = make_float2(s, q);
            }
        }
        __syncthreads();
    }
}

template <int KIND> __device__ __forceinline__ void run_gemm(unsigned char* shm, const pg8::Gemm& g, const Epi& e) {
    pg8::StaticOrder S; S.init(g.M, g.N, (int)gridDim.x, (int)blockIdx.x);
    BigEpi<KIND> E{e};
    if (e.stat) {
        const int c = (int)blockIdx.x, pm = 8 * (c & 7) + ((c >> 3) & 7);
        if (threadIdx.x < 256) { float mu, rstd; rowstat_full(e.stat, pm * 256 + (int)threadIdx.x, mu, rstd); ((float2*)(shm + TAB_OFF))[threadIdx.x] = make_float2(mu, rstd); }
        __syncthreads();
    }
    pg8::gemm_phase((PG8_LAS unsigned char*)shm, g, S, E);
    __syncthreads();
    small_gemm<KIND>(shm, g.A, g.Bt, g.N, g.K, e);
}

struct MatDesc { const float* src; bf16_t* dst; int K, N; const float* gain; const float* bias; float* c1; float* c2; int swiglu; };
__device__ __forceinline__ int mat_tiles(int id) { return id < 2 ? 64 : id < 4 ? 16 : id < 6 ? 32 : id < 8 ? 16 : id < 12 ? 88 : 16; }
__device__ __forceinline__ void get_mat(const Params& p, int id, MatDesc& m) {
    unsigned char* ws = p.ws; m.gain = nullptr; m.bias = nullptr; m.c1 = nullptr; m.c2 = nullptr; m.swiglu = 0;
    if (id < 2) { const int j = id; m.src = p.in[8] + (size_t)j * 1024 * 4096; m.dst = (bf16_t*)(ws + OFF_WT_A_IN) + (size_t)j * 4096 * 1024; m.K = 1024; m.N = 4096;
        if (j > 0) { m.gain = p.in[5] + (2 * j - 1) * 1024; m.bias = p.in[6] + (2 * j - 1) * 1024; }
        m.c1 = (float*)(ws + OFF_C1_A) + j * 4096; m.c2 = (float*)(ws + OFF_C2_A) + j * 4096; }
    else if (id < 4) { const int j = id - 2; m.src = p.in[10] + (size_t)j * 1024 * 1024; m.dst = (bf16_t*)(ws + OFF_WT_A_OUT) + (size_t)j * 1024 * 1024; m.K = 1024; m.N = 1024; }
    else if (id < 6) { const int j = id - 4; m.src = p.in[11] + (size_t)j * 1024 * 2048; m.dst = (bf16_t*)(ws + OFF_WT_B_IN) + (size_t)j * 2048 * 1024; m.K = 1024; m.N = 2048;
        m.gain = p.in[5] + (2 * j) * 1024; m.bias = p.in[6] + (2 * j) * 1024;
        m.c1 = (float*)(ws + OFF_C1_B) + j * 2048; m.c2 = (float*)(ws + OFF_C2_B) + j * 2048; }
    else if (id < 8) { const int j = id - 6; m.src = p.in[16] + (size_t)j * 1024 * 1024; m.dst = (bf16_t*)(ws + OFF_WT_B_OUT) + (size_t)j * 1024 * 1024; m.K = 1024; m.N = 1024; }
    else if (id < 12) { const int l = id - 8; m.src = p.in[17] + (size_t)l * 1024 * 5632; m.dst = (bf16_t*)(ws + OFF_WT_F_IN) + (size_t)l * 5632 * 1024; m.K = 1024; m.N = 5632;
        m.gain = p.in[3] + l * 1024; m.bias = p.in[4] + l * 1024;
        m.c1 = (float*)(ws + OFF_C1_F) + l * 5632; m.c2 = (float*)(ws + OFF_C2_F) + l * 5632; m.swiglu = 1; }
    else { const int l = id - 12; m.src = p.in[18] + (size_t)l * 2816 * 1024; m.dst = (bf16_t*)(ws + OFF_WT_F_OUT) + (size_t)l * 1024 * 2816; m.K = 2816; m.N = 1024; }
}
__device__ __forceinline__ void phase_prep(const Params& p, unsigned char* shm) {
    int tid_ = threadIdx.x; asm volatile("" : "+v"(tid_)); const int tid = tid_;
    unsigned short* tile = (unsigned short*)shm;
    float* red = (float*)(shm + 64 * 264 * 2);
    for (int task = blockIdx.x; task < 672; task += gridDim.x) {
        int id = 0, t = task; while (t >= mat_tiles(id)) { t -= mat_tiles(id); ++id; }
        MatDesc m; get_mat(p, id, m);
        const int n0 = t * 64;
        int nd0 = n0;
        if (m.swiglu) { const int c = n0 < 2816 ? n0 : n0 - 2816; nd0 = (c >> 7) * 256 + (c & 127) + (n0 < 2816 ? 0 : 128); }
        const int kk = tid >> 4, n4 = (tid & 15) * 4;
        float c1a[4] = {0.f, 0.f, 0.f, 0.f}, c2a[4] = {0.f, 0.f, 0.f, 0.f};
        float4 wq[8]; float gq[8], bq[8];
#pragma unroll
        for (int p8 = 0; p8 < 8; ++p8) { const int k = p8 * 32 + kk; wq[p8] = *(const float4*)(m.src + (size_t)k * m.N + n0 + n4); gq[p8] = m.gain ? m.gain[k] : 1.0f; bq[p8] = m.bias ? m.bias[k] : 0.0f; }
        for (int k0 = 0; k0 < m.K; k0 += 256) {
#pragma unroll
            for (int p8 = 0; p8 < 8; ++p8) {
                const float wv[4] = {wq[p8].x, wq[p8].y, wq[p8].z, wq[p8].w};
#pragma unroll
                for (int i = 0; i < 4; ++i) { const unsigned short r = f2bf(wv[i] * gq[p8]); tile[(n4 + i) * 264 + p8 * 32 + kk] = r; c1a[i] += bf2f(r); c2a[i] += bq[p8] * wv[i]; }
            }
            if (k0 + 256 < m.K) {
#pragma unroll
                for (int p8 = 0; p8 < 8; ++p8) { const int k = k0 + 256 + p8 * 32 + kk; wq[p8] = *(const float4*)(m.src + (size_t)k * m.N + n0 + n4); gq[p8] = m.gain ? m.gain[k] : 1.0f; bq[p8] = m.bias ? m.bias[k] : 0.0f; }
            }
            asm volatile("s_waitcnt lgkmcnt(0)" ::: "memory"); __builtin_amdgcn_s_barrier(); asm volatile("" ::: "memory");
            const int n = tid >> 3, cl = n & 31, nrow = (n & 32) + 16 * ((cl >> 2) & 1) + 4 * (cl >> 3) + (cl & 3);
#pragma unroll
            for (int p2 = 0; p2 < 4; ++p2) { const int k8 = (tid & 7) * 8 + p2 * 64; const uint4 v = *(const uint4*)&tile[n * 264 + k8]; *(uint4*)(m.dst + (size_t)(nd0 + nrow) * m.K + k0 + k8) = v; }
            asm volatile("s_waitcnt lgkmcnt(0)" ::: "memory"); __builtin_amdgcn_s_barrier(); asm volatile("" ::: "memory");
        }
        if (m.c1) {
#pragma unroll
            for (int i = 0; i < 4; ++i) { red[(0 * 32 + kk) * 64 + n4 + i] = c1a[i]; red[(1 * 32 + kk) * 64 + n4 + i] = c2a[i]; }
            __syncthreads();
            if (tid < 128) { const int which = tid >> 6, n = tid & 63; float s = 0.f; for (int k2 = 0; k2 < 32; ++k2) s += red[(which * 32 + k2) * 64 + n]; (which ? m.c2 : m.c1)[nd0 + n] = s; }
            __syncthreads();
        }
    }
    bf16_t* X0 = (bf16_t*)(p.ws + OFF_X0);
    for (size_t i = (size_t)blockIdx.x * 512 + tid; i < (size_t)MT * 256; i += (size_t)gridDim.x * 512) {
        const size_t e0 = i * 4; const float* src = e0 < (size_t)P * D ? p.in[0] + e0 : p.in[1] + (e0 - (size_t)P * D);
        st_bf4(X0 + e0, *(const f32x4*)src);
    }
    if (blockIdx.x == 0) {
        float* LB = (float*)(p.ws + OFF_LB);
        for (int c = tid; c < 1024; c += 512) {
            const float r0 = p.in[7][c], r1 = p.in[7][1024 + c], r2 = p.in[7][2048 + c], r3 = p.in[7][3072 + c];
            const float mx = fmaxf(fmaxf(r0, r1), fmaxf(r2, r3));
            const float e0 = expf(r0 - mx), e1 = expf(r1 - mx), e2 = expf(r2 - mx), e3 = expf(r3 - mx);
            LB[c] = 0.f; LB[1024 + c] = (e1 + e2) / (e0 + e1 + e2 + e3);
            float* ONES = (float*)(p.ws + OFF_ONES); ONES[c] = 1.0f; ONES[1024 + c] = 0.0f;
        }
    }
}

__device__ __forceinline__ void unpack8(const uint4 r, float* d) {
    *(float4*)d = make_float4(bf2f(r.x & 0xffffu), bf2f(r.x >> 16), bf2f(r.y & 0xffffu), bf2f(r.y >> 16));
    *(float4*)(d + 4) = make_float4(bf2f(r.z & 0xffffu), bf2f(r.z >> 16), bf2f(r.w & 0xffffu), bf2f(r.w >> 16));
}
__device__ __forceinline__ void phase_hgrn_pre(const Params& p, unsigned char* shm) {
    bf16_t* RAWq = (bf16_t*)shm;
    bf16_t* RAWk = RAWq + 64 * 128;
    bf16_t* Qm = RAWk + 64 * 128;
    bf16_t* Km = Qm + 64 * 136;
    bf16_t* KmT = Km + 64 * 136;
    bf16_t* AmL = KmT + 128 * 72;
    float* tot = (float*)(AmL + 64 * 72);
    bf16_t* Q = (bf16_t*)(p.ws + OFF_Q); const bf16_t* Kb = (const bf16_t*)(p.ws + OFF_K); bf16_t* KT = (bf16_t*)(p.ws + OFF_ZMIX); float* EV = (float*)(p.ws + OFF_STM);
    bf16_t* AM = (bf16_t*)(p.ws + OFF_AM);
    int tid_ = threadIdx.x; asm volatile("" : "+v"(tid_));
    const int tid = tid_, tq = tid >> 7, kcol = tid & 127, lt = tid >> 3, lseg = (tid & 7) * 16, wid = tid >> 6, lane = tid & 63, fr = lane & 15, fq = lane >> 4;
    for (int item = blockIdx.x; item < 2048; item += gridDim.x) {
        const int c = item & 31, h = (item >> 5) & 7, b = item >> 8;
        const size_t goff = (size_t)(b * 2048 + c * 64 + lt) * 1024 + h * 128 + lseg;
        *(uint4*)(RAWq + lt * 128 + lseg) = *(const uint4*)(Q + goff); *(uint4*)(RAWq + lt * 128 + lseg + 8) = *(const uint4*)(Q + goff + 8);
        *(uint4*)(RAWk + lt * 128 + lseg) = *(const uint4*)(Kb + goff); *(uint4*)(RAWk + lt * 128 + lseg + 8) = *(const uint4*)(Kb + goff + 8);
        __syncthreads();
        float lf[16], kv[16]; float cs = 0.f;
#pragma unroll
        for (int i = 0; i < 16; ++i) { kv[i] = bf2f(RAWk[(16 * tq + i) * 128 + kcol]); lf[i] = __builtin_amdgcn_logf(fmaxf(1.0f - kv[i], 1e-6f)); cs += lf[i]; }
        tot[tq * 128 + kcol] = cs;
        __syncthreads();
        {
            const float t0 = tot[kcol], t1 = tot[128 + kcol], t2 = tot[256 + kcol], t3 = tot[384 + kcol];
            float g = (tq > 0 ? t0 : 0.f) + (tq > 1 ? t1 : 0.f) + (tq > 2 ? t2 : 0.f);
            const float gmid = t0 + t1;
            if (tq == 0) { float* ev = EV + (size_t)(b * 32 + c) * 1024 + h * 128 + kcol; ev[0] = __builtin_amdgcn_exp2f(gmid); ev[262144] = __builtin_amdgcn_exp2f(t2 + t3); }
            unsigned kmt[8];
#pragma unroll
            for (int i = 0; i < 16; i += 2) {
                const int t = 16 * tq + i;
                const float ga = g + lf[i], gb = ga + lf[i + 1]; g = gb;
                const float qa = bf2f(RAWq[t * 128 + kcol]), qb = bf2f(RAWq[(t + 1) * 128 + kcol]);
                const unsigned pq = cvt_pk_bf16(qa * __builtin_amdgcn_exp2f(fminf(ga - gmid, 126.f)), qb * __builtin_amdgcn_exp2f(fminf(gb - gmid, 126.f)));
                const unsigned pk = cvt_pk_bf16(kv[i] * __builtin_amdgcn_exp2f(fminf(gmid - ga, 126.f)), kv[i + 1] * __builtin_amdgcn_exp2f(fminf(gmid - gb, 126.f)));
                Qm[t * 136 + kcol] = (bf16_t)(pq & 0xffffu); Qm[(t + 1) * 136 + kcol] = (bf16_t)(pq >> 16);
                Km[t * 136 + kcol] = (bf16_t)(pk & 0xffffu); Km[(t + 1) * 136 + kcol] = (bf16_t)(pk >> 16);
                kmt[i >> 1] = pk;
            }
            *(uint4*)(KmT + kcol * 72 + 16 * tq) = make_uint4(kmt[0], kmt[1], kmt[2], kmt[3]);
            *(uint4*)(KmT + kcol * 72 + 16 * tq + 8) = make_uint4(kmt[4], kmt[5], kmt[6], kmt[7]);
        }
        __syncthreads();
#pragma unroll
        for (int hf = 0; hf < 2; ++hf) {
            const int idx = wid + 8 * hf, tt = idx >> 2, st = idx & 3;
            f32x4 a = (f32x4){0.f, 0.f, 0.f, 0.f};
            if (st <= tt) {
#pragma unroll
                for (int k4 = 0; k4 < 4; ++k4) {
                    const bf16x8 X = *(const bf16x8*)(Km + (16 * st + fr) * 136 + 32 * k4 + 8 * fq), Y = *(const bf16x8*)(Qm + (16 * tt + fr) * 136 + 32 * k4 + 8 * fq);
                    a = __builtin_amdgcn_mfma_f32_16x16x32_bf16(X, Y, a, 0, 0, 0);
                }
            }
            const int t = 16 * tt + fr;
#pragma unroll
            for (int r = 0; r < 4; ++r) if (16 * st + 4 * fq + r > t) a[r] = 0.f;
            st_bf4(AmL + t * 72 + 16 * st + 4 * fq, a);
        }
        __syncthreads();
        *(uint4*)(Q + goff) = *(const uint4*)(Qm + lt * 136 + lseg); *(uint4*)(Q + goff + 8) = *(const uint4*)(Qm + lt * 136 + lseg + 8);
        { const int kk = tid >> 2, sg = (tid & 3) * 16; bf16_t* dst = KT + (size_t)item * 8192 + kk * 64 + sg;
          *(uint4*)dst = *(const uint4*)(KmT + kk * 72 + sg); *(uint4*)(dst + 8) = *(const uint4*)(KmT + kk * 72 + sg + 8); }
        *(uint4*)(AM + (size_t)item * 4096 + lt * 64 + (tid & 7) * 8) = *(const uint4*)(AmL + lt * 72 + (tid & 7) * 8);
        __syncthreads();
    }
}
__device__ __forceinline__ void phase_hgrn_prompt(const Params& p, unsigned char* shm, int j) {
    constexpr int SET = 64 * 136 + 128 * 72 + 64 * 72 + 32 * 72 + 32 * 136;
    const bf16_t* Q = (const bf16_t*)(p.ws + OFF_Q); const bf16_t* Vb = (const bf16_t*)(p.ws + OFF_V);
    const bf16_t* KT = (const bf16_t*)(p.ws + OFF_ZMIX); const float* EV = (const float*)(p.ws + OFF_STM); const bf16_t* AM = (const bf16_t*)(p.ws + OFF_AM);
    float* ORAW = (float*)(p.ws + OFF_H);
    int tid_ = threadIdx.x; asm volatile("" : "+v"(tid_));
    const int tid = tid_, wid = tid >> 6, lane = tid & 63, fr = lane & 15, fq = lane >> 4;
    const int lt = tid >> 3, lseg = (tid & 7) * 16, kk = tid >> 2, sg = (tid & 3) * 16, ks4 = 16 * wid + 4 * fq;
    for (int task = blockIdx.x; task < 256; task += gridDim.x) {
        const int bh = (task & 7) * 8 + (task >> 5), vq = (task >> 3) & 3, b = bh >> 3, h = bh & 7, rowbase = b * 2048;
        f32x4 S[2]; S[0] = (f32x4){0.f, 0.f, 0.f, 0.f}; S[1] = S[0];
        uint4 RA_q0, RA_q1, RA_t0, RA_t1, RA_a, RA_v = make_uint4(0, 0, 0, 0), RB_q0, RB_q1, RB_t0, RB_t1, RB_a, RB_v = make_uint4(0, 0, 0, 0);
        f32x4 RA_em, RA_ee, RB_em, RB_ee;
#define HG_LOAD(cc, R) do { \
            const size_t off = (size_t)(rowbase + (cc) * 64 + lt) * 1024 + h * 128 + lseg; \
            R##_q0 = *(const uint4*)(Q + off); R##_q1 = *(const uint4*)(Q + off + 8); \
            const bf16_t* kt = KT + (size_t)(bh * 32 + (cc)) * 8192 + kk * 64 + sg; R##_t0 = *(const uint4*)kt; R##_t1 = *(const uint4*)(kt + 8); \
            R##_a = *(const uint4*)(AM + (size_t)(bh * 32 + (cc)) * 4096 + lt * 64 + (tid & 7) * 8); \
            if (tid < 256) R##_v = *(const uint4*)(Vb + (size_t)(rowbase + (cc) * 64 + (tid >> 2)) * 1024 + h * 128 + vq * 32 + (tid & 3) * 8); \
            const float* ev = EV + (size_t)(b * 32 + (cc)) * 1024 + h * 128 + ks4; R##_em = *(const f32x4*)ev; R##_ee = *(const f32x4*)(ev + 262144); \
} while (0)
#define HG_BODY(c, R) do { \
            bf16_t* Qm = (bf16_t*)shm + ((c) & 1) * SET; bf16_t* KmT = Qm + 64 * 136; bf16_t* Am = KmT + 128 * 72; bf16_t* VT = Am + 64 * 72; bf16_t* SpT = VT + 32 * 72; \
            *(uint4*)(Qm + lt * 136 + lseg) = R##_q0; *(uint4*)(Qm + lt * 136 + lseg + 8) = R##_q1; \
            *(uint4*)(KmT + kk * 72 + sg) = R##_t0; *(uint4*)(KmT + kk * 72 + sg + 8) = R##_t1; \
            *(uint4*)(Am + lt * 72 + (tid & 7) * 8) = R##_a; \
            if (tid < 256) { const int t = tid >> 2, c8 = (tid & 3) * 8; const unsigned w[4] = {R##_v.x, R##_v.y, R##_v.z, R##_v.w}; \
_Pragma("unroll") \
                for (int i = 0; i < 4; ++i) { VT[(c8 + 2 * i) * 72 + t] = (bf16_t)(w[i] & 0xffffu); VT[(c8 + 2 * i + 1) * 72 + t] = (bf16_t)(w[i] >> 16); } } \
            const f32x4 e_mid = R##_em, e_em = R##_ee, e_end = R##_em * R##_ee; \
_Pragma("unroll") \
            for (int it = 0; it < 2; ++it) { \
                st_bf4(SpT + (16 * it + fr) * 136 + ks4, e_mid * S[it]); } \
            asm volatile("s_waitcnt lgkmcnt(0)" ::: "memory"); __builtin_amdgcn_s_barrier(); asm volatile("" ::: "memory"); \
            if ((c) + 2 < 32) HG_LOAD(((c)) + 2, R); \
              \
            const int it = wid >> 2, tt = wid & 3; \
            bf16x8 YQ[4], XO[4], XS0[2], XS1[2], YS[2], YA[2]; \
_Pragma("unroll") \
            for (int k4 = 0; k4 < 4; ++k4) { \
                YQ[k4] = *(const bf16x8*)(Qm + (16 * tt + fr) * 136 + 32 * k4 + 8 * fq); XO[k4] = *(const bf16x8*)(SpT + (16 * it + fr) * 136 + 32 * k4 + 8 * fq); } \
_Pragma("unroll") \
            for (int k2 = 0; k2 < 2; ++k2) { XS0[k2] = *(const bf16x8*)(VT + (fr) * 72 + 32 * k2 + 8 * fq); XS1[k2] = *(const bf16x8*)(VT + (16 + fr) * 72 + 32 * k2 + 8 * fq); \
                YS[k2] = *(const bf16x8*)(KmT + (16 * wid + fr) * 72 + 32 * k2 + 8 * fq); YA[k2] = *(const bf16x8*)(Am + (16 * tt + fr) * 72 + 32 * k2 + 8 * fq); } \
            f32x4 o = (f32x4){0.f, 0.f, 0.f, 0.f}, d0 = o, d1 = o; \
_Pragma("unroll") \
            for (int k4 = 0; k4 < 4; ++k4) { \
                o = __builtin_amdgcn_mfma_f32_16x16x32_bf16(XO[k4], YQ[k4], o, 0, 0, 0); \
                if (k4 < 2) { d0 = __builtin_amdgcn_mfma_f32_16x16x32_bf16(YS[k4], XS0[k4], d0, 0, 0, 0); d1 = __builtin_amdgcn_mfma_f32_16x16x32_bf16(YS[k4], XS1[k4], d1, 0, 0, 0); \
                              o = __builtin_amdgcn_mfma_f32_16x16x32_bf16(it ? XS1[k4] : XS0[k4], YA[k4], o, 0, 0, 0); } } \
            S[0] = S[0] * e_end + d0 * e_em; S[1] = S[1] * e_end + d1 * e_em; \
            *(f32x4*)(ORAW + (size_t)(rowbase + (c) * 64 + 16 * tt + fr) * 1024 + h * 128 + vq * 32 + 16 * it + 4 * fq) = o; \
} while (0)
        HG_LOAD(0, RA); HG_LOAD(1, RB);
#pragma nounroll
        for (int c = 0; c < 32; c += 2) { const int c1 = c + 1; HG_BODY(c, RA); HG_BODY(c1, RB); }
#undef HG_LOAD
#undef HG_BODY
        float* so = p.out + OUT_HSP + ((size_t)((j * 8 + b) * 8 + h) * 128) * 128;
#pragma unroll
        for (int i2 = 0; i2 < 2; ++i2)
#pragma unroll
            for (int r = 0; r < 4; ++r) so[(size_t)(ks4 + r) * 128 + vq * 32 + 16 * i2 + fr] = S[i2][r];
        __syncthreads();
    }
}
__device__ __forceinline__ void phase_hgrn_sample(const Params& p, unsigned char* shm, int j) {
    float* qs = (float*)shm; float* ks = qs + 128; float* red = ks + 128; float* ssq = red + 16 * 128;
    const bf16_t* Q = (const bf16_t*)(p.ws + OFF_Q); const bf16_t* Kb = (const bf16_t*)(p.ws + OFF_K); const bf16_t* Vb = (const bf16_t*)(p.ws + OFF_V); const bf16_t* G = (const bf16_t*)(p.ws + OFF_G);
    bf16_t* O = (bf16_t*)(p.ws + OFF_O);
    int tid_ = threadIdx.x; asm volatile("" : "+v"(tid_));
    const int tid = tid_, c4 = (tid & 31) * 4, kr = tid >> 5;
    for (int task = blockIdx.x; task < 1024; task += gridDim.x) {
        const int b = task >> 3, h = task & 7; const size_t rowoff = (size_t)(P + b) * 1024 + h * 128;
        if (tid < 128) { qs[tid] = bf2f(Q[rowoff + tid]); ks[tid] = bf2f(Kb[rowoff + tid]); }
        const f32x4 v4 = ld_bf4(Vb + rowoff + c4);
        __syncthreads();
        const float* Sin = p.in[2] + ((size_t)(j * 128 + b) * 8 + h) * 16384; float* Sout = p.out + OUT_HSS + ((size_t)(j * 128 + b) * 8 + h) * 16384;
        f32x4 o4 = (f32x4){0.f, 0.f, 0.f, 0.f};
#pragma unroll
        for (int i = 0; i < 8; ++i) { const int k = kr + 16 * i; f32x4 s = *(const f32x4*)(Sin + k * 128 + c4); s = s + (v4 - s) * ks[k]; *(f32x4*)(Sout + k * 128 + c4) = s; o4 += s * qs[k]; }
        *(f32x4*)(red + kr * 128 + c4) = o4;
        __syncthreads();
        float o = 0.f;
        if (tid < 128) {
#pragma unroll
            for (int r = 0; r < 16; ++r) o += red[r * 128 + tid];
            float ss = o * o;
#pragma unroll
            for (int off = 1; off < 64; off <<= 1) ss += __shfl_xor(ss, off);
            if ((tid & 63) == 0) ssq[tid >> 6] = ss;
        }
        __syncthreads();
        if (tid < 128) {
            const float r = rsqrtf((ssq[0] + ssq[1]) * (1.0f / 128.0f) + RMS_EPS);
            O[rowoff + tid] = f2bf(o * r * p.in[9][j * 128 + tid] * bf2f(G[rowoff + tid]));
        }
        __syncthreads();
    }
}
__device__ __forceinline__ void phase_rms(const Params& p, int j) {
    const float* ORAW = (const float*)(p.ws + OFF_H); const bf16_t* G = (const bf16_t*)(p.ws + OFF_G); bf16_t* O = (bf16_t*)(p.ws + OFF_O);
    int tid_ = threadIdx.x; asm volatile("" : "+v"(tid_)); const int tid = tid_;
    const f32x4 ng = *(const f32x4*)(p.in[9] + j * 128 + (tid & 31) * 4);
    for (int it = blockIdx.x; it < P * 8 / 16; it += gridDim.x) {
        const int pair = it * 16 + (tid >> 5), row = pair >> 3, h = pair & 7; const size_t off = (size_t)row * 1024 + h * 128 + (tid & 31) * 4;
        const f32x4 o4 = *(const f32x4*)(ORAW + off);
        float ss = (o4[0] * o4[0] + o4[1] * o4[1]) + (o4[2] * o4[2] + o4[3] * o4[3]);
#pragma unroll
        for (int o = 1; o < 32; o <<= 1) ss += __shfl_xor(ss, o);
        const float r = rsqrtf(ss * (1.0f / 128.0f) + RMS_EPS);
        st_bf4(O + off, o4 * r * ng * ld_bf4(G + off));
    }
}

__device__ __forceinline__ void phase_spatial(const Params& p, unsigned char* shm, int jb) {
    bf16_t* vnT = (bf16_t*)shm;
    float2* st = (float2*)(shm + 128 * 136 * 2);
    const bf16_t* U = (const bf16_t*)(p.ws + OFF_Q); const bf16_t* Vb = (const bf16_t*)(p.ws + OFF_K); bf16_t* O = (bf16_t*)(p.ws + OFF_O);
    const float2* STV = (const float2*)(p.ws + OFF_STV);
    const float* lng = p.in[12] + jb * 1024; const float* lnb = p.in[13] + jb * 1024; const float* wsp = p.in[14] + (size_t)jb * 8 * 128 * 128; const float* bsp = p.in[15] + jb * 8 * 128;
    float* cvp = p.out + OUT_CVP + (size_t)jb * 8 * 128 * 1024;
    int tid_ = threadIdx.x; asm volatile("" : "+v"(tid_));
    const int tid = tid_, wid = tid >> 6, lane = tid & 63, fr = lane & 15, fq = lane >> 4;
    for (int task = blockIdx.x; task < 256; task += gridDim.x) {
        const int gh = task & 1, cn = task >> 1, b = cn >> 4, n = cn & 15, r0 = b * 2048 + n * 128;
        if (tid < 128) { float mu, rstd; rowstat_full(STV, r0 + tid, mu, rstd); st[tid] = make_float2(mu, rstd); }
        __syncthreads();
        for (int gi = 0; gi < 4; ++gi) {
            const int g = gh * 4 + gi, c0 = g * 128;
            for (int item = tid; item < 1024; item += 512) {
                const int c = (item & 63) * 2, s8 = (item >> 6) * 8;
                const float g0 = lng[c0 + c], g1 = lng[c0 + c + 1], b0 = lnb[c0 + c], b1 = lnb[c0 + c + 1];
                unsigned w0[4], w1[4];
#pragma unroll
                for (int s2 = 0; s2 < 4; ++s2) {
                    float a0[2], a1[2];
#pragma unroll
                    for (int e = 0; e < 2; ++e) {
                        const int s = s8 + s2 * 2 + e; const unsigned vv = *(const unsigned*)(Vb + (size_t)(r0 + s) * 1024 + c0 + c); const float2 ms = st[s];
                        a0[e] = (bf2f(vv & 0xffffu) - ms.x) * ms.y * g0 + b0; a1[e] = (bf2f(vv >> 16) - ms.x) * ms.y * g1 + b1;
                        if (n == 15) *(float2*)(cvp + ((size_t)(b * 128 + s)) * 1024 + c0 + c) = make_float2(a0[e], a1[e]);
                    }
                    w0[s2] = cvt_pk_bf16(a0[0], a0[1]); w1[s2] = cvt_pk_bf16(a1[0], a1[1]);
                }
                *(uint4*)(vnT + c * 136 + s8) = make_uint4(w0[0], w0[1], w0[2], w0[3]);
                *(uint4*)(vnT + (c + 1) * 136 + s8) = make_uint4(w1[0], w1[1], w1[2], w1[3]);
            }
            __syncthreads();
            const int t = 16 * wid + fr;
            f32x4 acc[8];
#pragma unroll
            for (int ct = 0; ct < 8; ++ct) acc[ct] = (f32x4){0.f, 0.f, 0.f, 0.f};
            for (int ks = 0; ks <= (wid >> 1); ++ks) {
                const float* wp = wsp + ((size_t)g * 128 + t) * 128 + 32 * ks + 8 * fq;
                const float4 wa = *(const float4*)wp, wb = *(const float4*)(wp + 4);
                const float wv[8] = {wa.x, wa.y, wa.z, wa.w, wb.x, wb.y, wb.z, wb.w};
                const int sb = 32 * ks + 8 * fq;
                bf16x8 af;
#pragma unroll
                for (int i = 0; i < 8; ++i) af[i] = (short)f2bf((sb + i) <= t ? wv[i] : 0.f);
#pragma unroll
                for (int ct = 0; ct < 8; ++ct) {
                    const bf16x8 bfv = *(const bf16x8*)(vnT + (16 * ct + fr) * 136 + 32 * ks + 8 * fq);
                    acc[ct] = __builtin_amdgcn_mfma_f32_16x16x32_bf16(bfv, af, acc[ct], 0, 0, 0);
                }
            }
            const float bias = bsp[g * 128 + t];
#pragma unroll
            for (int ct = 0; ct < 8; ++ct) {
                const size_t off = (size_t)(r0 + t) * 1024 + c0 + 16 * ct + 4 * fq;
                st_bf4(O + off, ld_bf4(U + off) * (acc[ct] + bias));
            }
            __syncthreads();
        }
    }
    if (blockIdx.x < SR) {
        const int i = blockIdx.x, row = P + i; float mu, rstd; rowstat_full(STV, row, mu, rstd);
        float* cvs = p.out + OUT_CVS + (size_t)jb * 128 * 1024 + (size_t)i * 1024;
        const int c = tid * 2, g = c >> 7;
        const unsigned vv = *(const unsigned*)(Vb + (size_t)row * 1024 + c), uu = *(const unsigned*)(U + (size_t)row * 1024 + c);
        const float n0 = (bf2f(vv & 0xffffu) - mu) * rstd * lng[c] + lnb[c], n1 = (bf2f(vv >> 16) - mu) * rstd * lng[c + 1] + lnb[c + 1];
        *(float2*)(cvs + c) = make_float2(n0, n1);
        const float w00 = wsp[(size_t)g * 128 * 128], bb = bsp[g * 128];
        *(unsigned*)(O + (size_t)row * 1024 + c) = cvt_pk_bf16(bf2f(uu & 0xffffu) * (w00 * n0 + bb), bf2f(uu >> 16) * (w00 * n1 + bb));
    }
}

__device__ __forceinline__ void phase_ln_mat(const Params& p, size_t zoff, size_t stoff, const float* g, const float* bb, int nb) {
    const bf16_t* Z = (const bf16_t*)(p.ws + zoff); const float2* ST = (const float2*)(p.ws + stoff); bf16_t* X = (bf16_t*)(p.ws + OFF_X0);
    int tid_ = threadIdx.x; asm volatile("" : "+v"(tid_));
    const int tid = tid_, wid = tid >> 6, lane = tid & 63, bi = (int)gridDim.x - 1 - (int)blockIdx.x;
    if (bi >= nb) return;
    const int c0 = lane * 8;
    const f32x4 g0 = *(const f32x4*)(g + c0), g1 = *(const f32x4*)(g + c0 + 4), g2 = *(const f32x4*)(g + 512 + c0), g3 = *(const f32x4*)(g + 512 + c0 + 4);
    const f32x4 b0 = *(const f32x4*)(bb + c0), b1 = *(const f32x4*)(bb + c0 + 4), b2 = *(const f32x4*)(bb + 512 + c0), b3 = *(const f32x4*)(bb + 512 + c0 + 4);
    for (int row0 = (bi * 8 + wid) * 2; row0 < MT; row0 += nb * 16) {
        float2 pr[2]; uint4 za[2], zb[2];
#pragma unroll
        for (int r = 0; r < 2; ++r) { const int row = row0 + r;
            pr[r] = ST[(size_t)row * 16 + (lane & 15)]; za[r] = *(const uint4*)(Z + (size_t)row * 1024 + c0); zb[r] = *(const uint4*)(Z + (size_t)row * 1024 + 512 + c0); }
#pragma unroll
        for (int r = 0; r < 2; ++r) { const int row = row0 + r;
            float s = pr[r].x, q = pr[r].y;
#pragma unroll
            for (int o = 1; o < 16; o <<= 1) { s += __shfl_xor(s, o); q += __shfl_xor(q, o); }
            float mu, rstd; stat_finish(s, q, mu, rstd);
            const f32x4 z0 = (f32x4){bf2f(za[r].x & 0xffffu), bf2f(za[r].x >> 16), bf2f(za[r].y & 0xffffu), bf2f(za[r].y >> 16)}, z1 = (f32x4){bf2f(za[r].z & 0xffffu), bf2f(za[r].z >> 16), bf2f(za[r].w & 0xffffu), bf2f(za[r].w >> 16)};
            const f32x4 z2 = (f32x4){bf2f(zb[r].x & 0xffffu), bf2f(zb[r].x >> 16), bf2f(zb[r].y & 0xffffu), bf2f(zb[r].y >> 16)}, z3 = (f32x4){bf2f(zb[r].z & 0xffffu), bf2f(zb[r].z >> 16), bf2f(zb[r].w & 0xffffu), bf2f(zb[r].w >> 16)};
            const f32x4 x0 = (z0 - mu) * rstd * g0 + b0, x1 = (z1 - mu) * rstd * g1 + b1, x2 = (z2 - mu) * rstd * g2 + b2, x3 = (z3 - mu) * rstd * g3 + b3;
            uint4 w0, w1; w0.x = cvt_pk_bf16(x0[0], x0[1]); w0.y = cvt_pk_bf16(x0[2], x0[3]); w0.z = cvt_pk_bf16(x1[0], x1[1]); w0.w = cvt_pk_bf16(x1[2], x1[3]);
            w1.x = cvt_pk_bf16(x2[0], x2[1]); w1.y = cvt_pk_bf16(x2[2], x2[3]); w1.z = cvt_pk_bf16(x3[0], x3[1]); w1.w = cvt_pk_bf16(x3[2], x3[3]);
            *(uint4*)(X + (size_t)row * 1024 + c0) = w0; *(uint4*)(X + (size_t)row * 1024 + 512 + c0) = w1;
        }
    }
}

__device__ __forceinline__ void phase_final(const Params& p) {
    const bf16_t* Z = (const bf16_t*)(p.ws + OFF_ZFFN); const float2* STF = (const float2*)(p.ws + OFF_STF);
    const float* g = p.in[5] + 3 * 1024; const float* bb = p.in[6] + 3 * 1024;
    int tid_ = threadIdx.x; asm volatile("" : "+v"(tid_));
    const int tid = tid_, wid = tid >> 6, lane = tid & 63;
    for (int row = blockIdx.x * 8 + wid; row < MT; row += gridDim.x * 8) {
        float s = 0.f, q = 0.f;
        if (lane < 16) { const float2 pr = STF[(size_t)row * 16 + lane]; s = pr.x; q = pr.y; }
#pragma unroll
        for (int o = 1; o < 16; o <<= 1) { s += __shfl_xor(s, o); q += __shfl_xor(q, o); }
        s = __shfl(s, 0); q = __shfl(q, 0);
        float mu, rstd; stat_finish(s, q, mu, rstd);
#pragma unroll
        for (int hf = 0; hf < 2; ++hf) {
            const int c = hf * 512 + lane * 8; const uint4 z8 = *(const uint4*)(Z + (size_t)row * 1024 + c);
            const f32x4 za = (f32x4){bf2f(z8.x & 0xffffu), bf2f(z8.x >> 16), bf2f(z8.y & 0xffffu), bf2f(z8.y >> 16)}, zb = (f32x4){bf2f(z8.z & 0xffffu), bf2f(z8.z >> 16), bf2f(z8.w & 0xffffu), bf2f(z8.w >> 16)};
            float* o = p.out + (size_t)row * 1024 + c;
            *(f32x4*)o = (za - mu) * rstd * *(const f32x4*)(g + c) + *(const f32x4*)(bb + c);
            *(f32x4*)(o + 4) = (zb - mu) * rstd * *(const f32x4*)(g + c + 4) + *(const f32x4*)(bb + c + 4);
        }
    }
}

#define XB_TMO      128
#define XB_XCNT(j)  (256  + 64 * (j))
#define XB_XSUB(j)  (1280 + 64 * (j))
#define XB_XGEN(j)  (2304 + 64 * (j))
#define XB_TOP      3328
#define XB_TOPGEN   3392
#define XCD_BAR_WORDS 3456
#define XB_SPIN_CAP (1u << 18)

__device__ __forceinline__ unsigned xb_ld(unsigned* p)              { return __hip_atomic_load(p, __ATOMIC_RELAXED, __HIP_MEMORY_SCOPE_AGENT); }
__device__ __forceinline__ unsigned xb_add(unsigned* p, unsigned v) { return __hip_atomic_fetch_add(p, v, __ATOMIC_RELAXED, __HIP_MEMORY_SCOPE_AGENT); }
__device__ __forceinline__ unsigned xb_xcc_id() { return (unsigned)__builtin_amdgcn_s_getreg((3 << 11) | 20) & 0xFu; }
#define XB_SPIN(cond, bar) do { unsigned _sp = 0; while (cond) { __builtin_amdgcn_s_sleep(1); \
    if ((++_sp & 255u) == 0u) { if (xb_ld(&(bar)[XB_TMO])) break; if (_sp > XB_SPIN_CAP) { atomicAdd(&(bar)[XB_TMO], 1u); break; } } } } while (0)

struct XcdBarrier {
    unsigned* bar; unsigned x;
    volatile PG8_LAS unsigned* st;
};

__device__ __forceinline__ XcdBarrier xcd_barrier_post(unsigned* bar, volatile PG8_LAS unsigned* st) {
    XcdBarrier b; b.bar = bar; b.x = xb_xcc_id(); b.st = st;
    if (threadIdx.x == 0) (void)xb_add(&bar[XB_XCNT(b.x)], 1u);
    return b;
}
__device__ __forceinline__ void xcd_barrier_complete(unsigned* bar, unsigned x, unsigned& nloc, unsigned& nx) {
    const unsigned G = gridDim.x * gridDim.y * gridDim.z;
    unsigned sum, cnt, mine, sp = 0u;
    for (;;) {
        sum = 0u; cnt = 0u; mine = 0u;
#pragma unroll
        for (unsigned j = 0; j < 16; ++j) { const unsigned c = xb_ld(&bar[XB_XCNT(j)]); sum += c; cnt += (c > 0u) ? 1u : 0u; mine = (j == x) ? c : mine; }
        if (sum == G) break;
        __builtin_amdgcn_s_sleep(1);
        if ((++sp & 255u) == 0u) { if (xb_ld(&bar[XB_TMO])) break; if (sp > XB_SPIN_CAP) { atomicAdd(&bar[XB_TMO], 1u); break; } }
    }
    nloc = mine > 0u ? mine : 1u; nx = cnt > 0u ? cnt : 1u;
}

__device__ __forceinline__ void xcd_barrier(const XcdBarrier& b) {
    asm volatile("s_waitcnt vmcnt(0)" ::: "memory");
    __syncthreads();
    if (threadIdx.x == 0) {
        unsigned* bar = b.bar;
        __builtin_amdgcn_s_waitcnt(0);
        unsigned nloc = b.st[0], nx = b.st[1];
        if (nloc == 0u) { xcd_barrier_complete(bar, b.x, nloc, nx); b.st[0] = nloc; b.st[1] = nx; }
        const unsigned old = xb_add(&bar[XB_XSUB(b.x)], 1u);
        const unsigned gen = old / nloc;
        if (old + 1u == (gen + 1u) * nloc) {
            __builtin_amdgcn_fence(__ATOMIC_RELEASE, "agent");
            asm volatile("s_waitcnt vmcnt(0)" ::: "memory");
            const unsigned og = xb_add(&bar[XB_TOP], 1u);
            const unsigned tg = og / nx;
            if (og + 1u == (tg + 1u) * nx) xb_add(&bar[XB_TOPGEN], 1u);
            else XB_SPIN(xb_ld(&bar[XB_TOPGEN]) == tg, bar);
            __builtin_amdgcn_fence(__ATOMIC_ACQUIRE, "agent");
            xb_add(&bar[XB_XGEN(b.x)], 1u);
            asm volatile("s_waitcnt vmcnt(0)" ::: "memory");
        } else {
            XB_SPIN(xb_ld(&bar[XB_XGEN(b.x)]) == gen, bar);
            __builtin_amdgcn_fence(__ATOMIC_ACQUIRE, "agent");
            asm volatile("s_waitcnt vmcnt(0)" ::: "memory");
        }
    }
    __syncthreads();
}

__global__ void __launch_bounds__(512, 2) hgrn2_chunkmlp_mega(Params p) {
    extern __shared__ __attribute__((aligned(16))) unsigned char shm[];
    cg::grid_group grid = cg::this_grid();
#define WSL(name) unsigned char* name = p.ws; asm volatile("" : "+s"(name))
    unsigned* xb_st = (unsigned*)(shm + 131072);
    if (threadIdx.x < 2) xb_st[threadIdx.x] = 0u;
    if (p.out == nullptr) grid.sync();
    const XcdBarrier xbar = xcd_barrier_post((unsigned*)(p.ws + OFF_BAR), (volatile PG8_LAS unsigned*)xb_st);
    phase_prep(p, shm);
    xcd_barrier(xbar);
#define GRID_SYNC() xcd_barrier(xbar)
#pragma nounroll
    for (int l = 0; l < 4; ++l) {
        const int j = l >> 1;
        if ((l & 1) == 0) {
            WSL(ws);
            pg8::Gemm g; g.A = (const bf16_t*)(ws + (l == 0 ? OFF_X0 : OFF_ZFFN)); g.Bt = (const bf16_t*)(ws + OFF_WT_A_IN) + (size_t)j * 4096 * 1024; g.M = P; g.N = 4096; g.K = 1024;
            Epi e{}; e.stat = l == 0 ? nullptr : (const float2*)(ws + OFF_STF); e.a = (const float*)(ws + OFF_C1_A) + j * 4096; e.b = (const float*)(ws + OFF_C2_A) + j * 4096;
            e.o = (bf16_t*)(ws + OFF_Q); e.x = (const float*)(ws + OFF_LB) + j * 1024;
            run_gemm<0>(shm, g, e);
            GRID_SYNC();
            phase_hgrn_pre(p, shm);
            GRID_SYNC();
            phase_hgrn_prompt(p, shm, j);
            phase_hgrn_sample(p, shm, j);
            GRID_SYNC();
            phase_rms(p, j);
            GRID_SYNC();
        } else {
            WSL(ws);
            pg8::Gemm g; g.A = (const bf16_t*)(ws + OFF_ZFFN); g.Bt = (const bf16_t*)(ws + OFF_WT_B_IN) + (size_t)j * 2048 * 1024; g.M = P; g.N = 2048; g.K = 1024;
            Epi e{}; e.stat = (const float2*)(ws + OFF_STF); e.a = (const float*)(ws + OFF_C1_B) + j * 2048; e.b = (const float*)(ws + OFF_C2_B) + j * 2048;
            e.o = (bf16_t*)(ws + OFF_Q); e.opart = (float2*)(ws + OFF_STV);
            run_gemm<3>(shm, g, e);
            GRID_SYNC();
            phase_spatial(p, shm, j);
            GRID_SYNC();
        }
#pragma nounroll
        for (int r = 0; r < 2; ++r) {
            if (r == 1) {
                WSL(ws);
                pg8::Gemm g; g.A = (const bf16_t*)(ws + OFF_ZMIX); g.Bt = (const bf16_t*)(ws + OFF_WT_F_IN) + (size_t)l * 5632 * 1024; g.M = P; g.N = 5632; g.K = 1024;
                Epi e{}; e.stat = (const float2*)(ws + OFF_STM); e.a = (const float*)(ws + OFF_C1_F) + l * 5632; e.b = (const float*)(ws + OFF_C2_F) + l * 5632; e.o = (bf16_t*)(ws + OFF_H);
                run_gemm<2>(shm, g, e);
                GRID_SYNC();
            }
            WSL(ws);
            pg8::Gemm g; Epi e{}; g.M = P; g.N = 1024;
            if (r == 0) {
                g.A = (const bf16_t*)(ws + OFF_O); g.Bt = (const bf16_t*)(ws + ((l & 1) ? OFF_WT_B_OUT : OFF_WT_A_OUT)) + (size_t)j * 1024 * 1024; g.K = 1024;
                if (l == 0) { e.x = ws + OFF_X0; e.a = (const float*)(ws + OFF_ONES); e.b = (const float*)(ws + OFF_ONES) + 1024; }
                else { e.x = ws + OFF_ZFFN; e.stat = (const float2*)(ws + OFF_STF); e.a = p.in[5] + (l - 1) * 1024; e.b = p.in[6] + (l - 1) * 1024; }
                e.o = (bf16_t*)(ws + OFF_ZMIX); e.opart = (float2*)(ws + OFF_STM);
            } else {
                g.A = (const bf16_t*)(ws + OFF_H); g.Bt = (const bf16_t*)(ws + OFF_WT_F_OUT) + (size_t)l * 1024 * 2816; g.K = 2816;
                e.x = ws + OFF_ZMIX; e.stat = (const float2*)(ws + OFF_STM); e.a = p.in[3] + l * 1024; e.b = p.in[4] + l * 1024;
                e.o = (bf16_t*)(ws + OFF_ZFFN); e.opart = (float2*)(ws + OFF_STF);
            }
            run_gemm<1>(shm, g, e);
            GRID_SYNC();
        }
    }
    phase_final(p);
}

extern "C" void kernel_launch(void* const* d_in, const int* in_sizes, int n_in, void* d_out, int out_size, void* d_ws, size_t ws_size, hipStream_t stream) {
    static int grid = 0;
    if (grid == 0) {
        if (n_in != 19 || ws_size < WS_END) { fprintf(stderr, "kernel_launch: need 19 inputs and %zu bytes of workspace (got %d, %zu)\n", (size_t)WS_END, n_in, ws_size); grid = -1; return; }
        int dev = 0, cus = 0, per_cu = 0;
        hipGetDevice(&dev); hipDeviceGetAttribute(&cus, hipDeviceAttributeMultiprocessorCount, dev);
        if (hipFuncSetAttribute((const void*)hgrn2_chunkmlp_mega, hipFuncAttributeMaxDynamicSharedMemorySize, LDS_BYTES) != hipSuccess) { fprintf(stderr, "kernel_launch: hipFuncSetAttribute failed\n"); grid = -1; return; }
        if (hipOccupancyMaxActiveBlocksPerMultiprocessor(&per_cu, (const void*)hgrn2_chunkmlp_mega, 512, LDS_BYTES) != hipSuccess || per_cu < 1) { fprintf(stderr, "kernel_launch: occupancy query says %d blocks per CU\n", per_cu); grid = -1; return; }
        grid = cus;
        if (grid != 256) { fprintf(stderr, "kernel_launch: built for a 256-CU device (got %d CUs)\n", cus); grid = -1; return; }
    }
    if (grid < 0) return;
    Params p{};
    for (int i = 0; i < 19; ++i) p.in[i] = (const float*)d_in[i];
    p.out = (float*)d_out; p.ws = (unsigned char*)d_ws;
    void* args[] = {&p};
    if (hipMemsetAsync((char*)d_ws + OFF_BAR, 0, 16384, stream) != hipSuccess) { fprintf(stderr, "kernel_launch: hipMemsetAsync of the barrier words failed\n"); return; }
    hipError_t e = hipLaunchCooperativeKernel((void*)hgrn2_chunkmlp_mega, dim3(grid), dim3(512), args, LDS_BYTES, stream);
    if (e != hipSuccess) fprintf(stderr, "cooperative launch failed: %s (grid %d)\n", hipGetErrorString(e), grid);
}
```

```cpp
#include <hip/hip_runtime.h>
#include <hip/hip_cooperative_groups.h>
#include <cstdio>
namespace cg = cooperative_groups;

typedef unsigned short bf16_t;
typedef short bf16x8 __attribute__((ext_vector_type(8)));
typedef float f32x4 __attribute__((ext_vector_type(4)));
typedef float f32x2 __attribute__((ext_vector_type(2)));

constexpr int P = 16384, SR = 128, MT = P + SR, D = 1024, DFF = 2816;
constexpr float ALPHA = 1.681792830507429f;
constexpr float LN_EPS = 1e-5f, RMS_EPS = 1e-6f;
constexpr int LDS_BYTES = 131072 + 64 + 2048;

constexpr size_t al256(size_t x) { return (x + 255) & ~(size_t)255; }
constexpr size_t SZ_ACT = (size_t)MT * D * 2;
constexpr size_t OFF_WT_A_IN = 0;
constexpr size_t OFF_WT_A_OUT = OFF_WT_A_IN + (size_t)2 * 4096 * 1024 * 2;
constexpr size_t OFF_WT_B_IN = OFF_WT_A_OUT + (size_t)2 * 1024 * 1024 * 2;
constexpr size_t OFF_WT_B_OUT = OFF_WT_B_IN + (size_t)2 * 2048 * 1024 * 2;
constexpr size_t OFF_WT_F_IN = OFF_WT_B_OUT + (size_t)2 * 1024 * 1024 * 2;
constexpr size_t OFF_WT_F_OUT = OFF_WT_F_IN + (size_t)4 * 5632 * 1024 * 2;
constexpr size_t OFF_C1_A = OFF_WT_F_OUT + (size_t)4 * 1024 * 2816 * 2;
constexpr size_t OFF_C2_A = OFF_C1_A + 2 * 4096 * 4;
constexpr size_t OFF_C1_B = OFF_C2_A + 2 * 4096 * 4;
constexpr size_t OFF_C2_B = OFF_C1_B + 2 * 2048 * 4;
constexpr size_t OFF_C1_F = OFF_C2_B + 2 * 2048 * 4;
constexpr size_t OFF_C2_F = OFF_C1_F + 4 * 5632 * 4;
constexpr size_t OFF_LB = OFF_C2_F + 4 * 5632 * 4;
constexpr size_t OFF_ONES = OFF_LB + 2 * 1024 * 4;
constexpr size_t OFF_X0 = al256(OFF_ONES + 2 * 1024 * 4);
constexpr size_t OFF_ZMIX = OFF_X0 + SZ_ACT;
constexpr size_t OFF_ZFFN = OFF_ZMIX + SZ_ACT;
constexpr size_t SZ_ST = (size_t)MT * 16 * 8;
constexpr size_t OFF_STM = OFF_ZFFN + SZ_ACT;
constexpr size_t OFF_STF = OFF_STM + SZ_ST;
constexpr size_t OFF_STV = OFF_STF + SZ_ST;
constexpr size_t OFF_Q = OFF_STV + SZ_ST;
constexpr size_t OFF_K = OFF_Q + SZ_ACT;
constexpr size_t OFF_V = OFF_K + SZ_ACT;
constexpr size_t OFF_G = OFF_V + SZ_ACT;
constexpr size_t OFF_O = OFF_G + SZ_ACT;
constexpr size_t OFF_H = OFF_O + SZ_ACT;
constexpr size_t OFF_BAR = al256(OFF_H + (size_t)MT * DFF * 2);
constexpr size_t OFF_AM = OFF_BAR + 16384;
constexpr size_t WS_END = OFF_AM + (size_t)2048 * 4096 * 2;

constexpr size_t OUT_YP = 0, OUT_YS = (size_t)P * D, OUT_HSP = OUT_YS + (size_t)SR * D, OUT_HSS = OUT_HSP + (size_t)2 * 8 * 8 * 16384,
                 OUT_CVP = OUT_HSS + (size_t)2 * 128 * 8 * 16384, OUT_CVS = OUT_CVP + (size_t)2 * 8 * 128 * 1024;

struct Params { const float* in[19]; float* out; unsigned char* ws; };

__device__ __forceinline__ float bf2f(unsigned b) { return __uint_as_float(b << 16); }
__device__ __forceinline__ unsigned short f2bf(float f) { unsigned u = __float_as_uint(f); u += 0x7FFFu + ((u >> 16) & 1u); return (unsigned short)(u >> 16); }
__device__ __forceinline__ unsigned cvt_pk_bf16(float lo, float hi) { unsigned r; asm volatile("v_cvt_pk_bf16_f32 %0, %1, %2" : "=v"(r) : "v"(lo), "v"(hi)); return r; }
__device__ __forceinline__ f32x4 ld_bf4(const bf16_t* p) { const uint2 w = *(const uint2*)p; return (f32x4){bf2f(w.x & 0xffffu), bf2f(w.x >> 16), bf2f(w.y & 0xffffu), bf2f(w.y >> 16)}; }
__device__ __forceinline__ void st_bf4(bf16_t* p, f32x4 v) { uint2 w; w.x = cvt_pk_bf16(v[0], v[1]); w.y = cvt_pk_bf16(v[2], v[3]); *(uint2*)p = w; }
typedef unsigned v4u __attribute__((ext_vector_type(4)));
__device__ __forceinline__ __amdgpu_buffer_rsrc_t wt_rsrc(void* base) { return __builtin_amdgcn_make_buffer_rsrc(base, 0, 0x7ffffff0, 0x00020000); }
__device__ __forceinline__ void st16_wt(__amdgpu_buffer_rsrc_t r, unsigned byteoff, v4u w) { __builtin_amdgcn_raw_buffer_store_b128(w, r, byteoff, 0, 16); }
template <int CTRL> __device__ __forceinline__ float dppf(float x) { return __builtin_bit_cast(float, __builtin_amdgcn_mov_dpp(__builtin_bit_cast(int, x), CTRL, 0xf, 0xf, true)); }

namespace pg8 {
#define PG8_LAS __attribute__((address_space(3)))
constexpr int BM = 256, BK = 64, HALF = 128, HTB = HALF * BK * 2, STAGE_BYTES = 8 * HTB, NXCD = 8, WGM = 8;
__host__ __device__ __forceinline__ int lds_byte(int r, int c) { const int st = (r >> 4) * 2 + (c >> 5), rr = r & 15, cc = c & 31, ob = rr * 64 + cc * 2; return st * 1024 + (ob ^ (((ob >> 9) & 1) << 5)); }
__host__ __device__ __forceinline__ void stage_rc(int b, int& R, int& C) { const int st = b / 1024, sb = b % 1024, swz = sb ^ (((sb >> 9) & 1) << 5); R = (st >> 1) * 16 + swz / 64; C = (st & 1) * 32 + (swz % 64) / 2; }
struct Unit { int pm, pn; };
struct Gemm { const bf16_t* A; const bf16_t* Bt; int M, N, K; };
struct StaticOrder {
    int nM, nN, nwg, G, c;
    __host__ __device__ void init(int M, int N, int G_, int c_) { nM = M / BM; nN = N / BM; nwg = nM * nN; G = G_; c = c_; }
    __host__ __device__ bool next(int i, Unit& u) const {
        const int L = i * G + c; if (L >= nwg) return false;
        const int xcd = L & 7, off = L >> 3;
        u.pm = xcd * 8 + (off & 7); u.pn = off >> 3; return true;
    }
    __device__ __forceinline__ void a_ready(const Unit&) const {}
    __device__ __forceinline__ void done(const Unit&) const {}
};
template <class Epi, class Sched>
__device__ __forceinline__ void gemm_phase(PG8_LAS unsigned char* lds, const Gemm g, const Sched& S, const Epi& E) {
    int tid_ = threadIdx.x; asm volatile("" : "+v"(tid_));
    const int tid = tid_, wid = __builtin_amdgcn_readfirstlane(tid >> 6), lane = tid & 63, wr = wid >> 2, wc = wid & 3, fr = lane & 15, fq = lane >> 4;
    const int K = g.K, nt = K / BK;
    unsigned voffA[2];
#pragma unroll
    for (int i = 0; i < 2; ++i) { int R, C; stage_rc(tid * 16 + i * 8192, R, C); voffA[i] = (unsigned)(R * K + C) * 2u; }
    const size_t kstep = (size_t)(BK * 2);
    const size_t hstep = (size_t)HALF * K * 2;
    const size_t tstep = 2 * hstep;
    const unsigned ldsw = (unsigned)wid * 1024u;
    const int aoff = lds_byte(wr * 64 + fr, fq * 8), boff = lds_byte(wc * 32 + fr, fq * 8);
#define PG8_SA(b, h) (((b) * 2 + (h)) * HTB)
#define PG8_SB(b, h) ((4 + (b) * 2 + (h)) * HTB)
#define PG8_STAGE(bufoff, gbase, voff) do { _Pragma("unroll") for (int _i = 0; _i < 2; ++_i) \
        __builtin_amdgcn_global_load_lds((const unsigned*)((const char*)(gbase) + (voff)[_i]), (PG8_LAS unsigned*)(lds + (bufoff) + ldsw + _i * 8192), 16, 0, 0); } while (0)
#define PG8_LDA(dst, b, h) do { _Pragma("unroll") for (int m = 0; m < 4; ++m) _Pragma("unroll") for (int k = 0; k < 2; ++k) dst[m][k] = *(const PG8_LAS bf16x8*)(lds + PG8_SA(b, h) + aoff + m * 2048 + k * 1024); } while (0)
#define PG8_LDB(dst, b, h) do { _Pragma("unroll") for (int n = 0; n < 2; ++n) _Pragma("unroll") for (int k = 0; k < 2; ++k) dst[n][k] = *(const PG8_LAS bf16x8*)(lds + PG8_SB(b, h) + boff + n * 2048 + k * 1024); } while (0)
#define PG8_MMA(ai, bj, At, Bt) do { __builtin_amdgcn_s_setprio(1); _Pragma("unroll") for (int m = 0; m < 4; ++m) _Pragma("unroll") for (int n = 0; n < 2; ++n) _Pragma("unroll") for (int k = 0; k < 2; ++k) \
        acc[ai][bj][m][n] = __builtin_amdgcn_mfma_f32_16x16x32_bf16(Bt[n][k], At[m][k], acc[ai][bj][m][n], 0, 0, 0); __builtin_amdgcn_s_setprio(0); } while (0)
#define PG8_WAIT_V(n) asm volatile("s_waitcnt vmcnt(" #n ")" ::: "memory")
#define PG8_WAIT_L(n) asm volatile("s_waitcnt lgkmcnt(" #n ")" ::: "memory")
#define PG8_BAR __builtin_amdgcn_s_barrier()
#define PG8_SCHED __builtin_amdgcn_sched_barrier(0)
    Unit cur, nxt; int ui = 0;
    if (!S.next(0, cur)) return;
    f32x4 acc[2][2][4][2];
#pragma unroll
    for (int a = 0; a < 2; ++a)
#pragma unroll
        for (int b = 0; b < 2; ++b)
#pragma unroll
            for (int m = 0; m < 4; ++m)
#pragma unroll
                for (int n = 0; n < 2; ++n) acc[a][b][m][n] = (f32x4){0.f, 0.f, 0.f, 0.f};
    bf16x8 At[4][2], B0[2][2], B1[2][2];
    const char* cA = (const char*)g.A + (size_t)cur.pm * tstep; const char* cB = (const char*)g.Bt + (size_t)cur.pn * tstep;
    S.a_ready(cur);
    PG8_STAGE(PG8_SB(0, 0), cB, voffA); PG8_STAGE(PG8_SA(0, 0), cA, voffA); PG8_STAGE(PG8_SB(0, 1), cB + hstep, voffA); PG8_STAGE(PG8_SA(0, 1), cA + hstep, voffA);
    if (wr == 1) PG8_BAR;
    PG8_WAIT_V(4); PG8_BAR;
    PG8_STAGE(PG8_SB(1, 0), cB + kstep, voffA); PG8_STAGE(PG8_SA(1, 0), cA + kstep, voffA); PG8_STAGE(PG8_SB(1, 1), cB + hstep + kstep, voffA);
    PG8_WAIT_V(6); PG8_BAR;
    for (;;) {
        const bool has_next = S.next(ui + 1, nxt);
        const char* nA = has_next ? (const char*)g.A + (size_t)nxt.pm * tstep : cA; const char* nB = has_next ? (const char*)g.Bt + (size_t)nxt.pn * tstep : cB;
        for (int t = 0; t < nt; t += 2) {
            const bool last = (t == nt - 2);
            const char* a1 = cA + (size_t)(t + 1) * kstep;
            const char* a2 = last ? nA : cA + (size_t)(t + 2) * kstep; const char* b2 = last ? nB : cB + (size_t)(t + 2) * kstep;
            const char* a3 = a2 + kstep; const char* b3 = b2 + kstep;
            if (last && has_next) S.a_ready(nxt);
            PG8_LDB(B0, 0, 0); PG8_SCHED; PG8_LDA(At, 0, 0); PG8_STAGE(PG8_SA(1, 1), a1 + hstep, voffA);
            PG8_WAIT_L(8); PG8_BAR; PG8_WAIT_L(0); PG8_MMA(0, 0, At, B0); PG8_BAR; PG8_SCHED;
            PG8_LDB(B1, 0, 1); PG8_STAGE(PG8_SB(0, 0), b2, voffA);
            PG8_BAR; PG8_WAIT_L(0); PG8_MMA(0, 1, At, B1); PG8_BAR;
            PG8_LDA(At, 0, 1); PG8_STAGE(PG8_SA(0, 0), a2, voffA);
            PG8_BAR; PG8_WAIT_L(0); PG8_MMA(1, 0, At, B0); PG8_BAR; PG8_SCHED;
            PG8_STAGE(PG8_SB(0, 1), b2 + hstep, voffA);
            PG8_WAIT_V(6); PG8_BAR; PG8_MMA(1, 1, At, B1); PG8_BAR;
            PG8_LDB(B0, 1, 0); PG8_SCHED; PG8_LDA(At, 1, 0); PG8_STAGE(PG8_SA(0, 1), a2 + hstep, voffA);
            PG8_WAIT_L(8); PG8_BAR; PG8_WAIT_L(0); PG8_MMA(0, 0, At, B0); PG8_BAR; PG8_SCHED;
            PG8_LDB(B1, 1, 1); PG8_STAGE(PG8_SB(1, 0), b3, voffA);
            PG8_BAR; PG8_WAIT_L(0); PG8_MMA(0, 1, At, B1); PG8_BAR;
            PG8_LDA(At, 1, 1); PG8_STAGE(PG8_SA(1, 0), a3, voffA);
            PG8_BAR; PG8_WAIT_L(0); PG8_MMA(1, 0, At, B0); PG8_BAR; PG8_SCHED;
            PG8_STAGE(PG8_SB(1, 1), b3 + hstep, voffA);
            PG8_WAIT_V(6); PG8_BAR; PG8_MMA(1, 1, At, B1); PG8_BAR;
        }
        E(acc, cur, wr, wc, fr, fq); S.done(cur);
        if (!has_next) break;
#pragma unroll
        for (int a = 0; a < 2; ++a)
#pragma unroll
            for (int b = 0; b < 2; ++b)
#pragma unroll
                for (int m = 0; m < 4; ++m)
#pragma unroll
                    for (int n = 0; n < 2; ++n) acc[a][b][m][n] = (f32x4){0.f, 0.f, 0.f, 0.f};
        cur = nxt; cA = nA; cB = nB; ++ui;
    }
    PG8_WAIT_V(0);
    if (wr == 0) PG8_BAR;
    PG8_BAR;
#undef PG8_SA
#undef PG8_SB
#undef PG8_STAGE
#undef PG8_LDA
#undef PG8_LDB
#undef PG8_MMA
#undef PG8_WAIT_V
#undef PG8_WAIT_L
#undef PG8_BAR
#undef PG8_SCHED
}
}

struct Epi {
    const float2* stat;
    const float* a;
    const float* b;
    bf16_t* o;
    float2* opart;
    const void* x;
};
__device__ __forceinline__ f32x4 sigm4(f32x4 x) { f32x4 r; for (int i = 0; i < 4; ++i) r[i] = __builtin_amdgcn_rcpf(1.0f + __expf(-x[i])); return r; }
__device__ __forceinline__ f32x4 gelu4(f32x4 v) {
    f32x4 o;
#pragma unroll
    for (int i = 0; i < 4; ++i) {
        const float x = v[i], av = fabsf(x), t = __builtin_amdgcn_rcpf(av * 0.2316418882f + 1.0f);
        float q = t * 0.5307027145f + (-0.7265760135f); q = q * t + 0.7107068705f; q = q * t + (-0.142248368f); q = q * t + 0.127414796f; q = q * t;
        const float e = __builtin_amdgcn_exp2f(x * x * (-0.72134752044f));
        const float m = x * (q * e);
        o[i] = x < 0.f ? m : x - m;
    }
    return o;
}
template <int KIND> __device__ __forceinline__ f32x4 epi_val(int col, f32x4 a, float mu, float rstd, f32x4 va, f32x4 vb, f32x4 vx) {
    if constexpr (KIND == 0) {
        const f32x4 val = (a - va * mu) * rstd + vb;
        const int seg = col >> 10;
        if (seg == 0) return val * sigm4(val) * 0.08838834764831845f;
        else if (seg == 1) return (1.0f - vx) * sigm4(-val);
        else if (seg == 2) return val;
        else return val * sigm4(val);
    } else if constexpr (KIND == 1) {
        return ((vx - mu) * rstd * va + vb) * ALPHA + a;
    } else {
        return gelu4((a - va * mu) * rstd + vb);
    }
}
template <int KIND> __device__ __forceinline__ bf16_t* epi_ptr(const Epi& e, int row, int col) {
    if constexpr (KIND == 1) return e.o + (size_t)row * 1024 + col;
    else return e.o + (size_t)(col >> 10) * ((size_t)MT * 1024) + (size_t)row * 1024 + (col & 1023);
}
template <int KIND> __device__ __forceinline__ unsigned epi_off(int row, int col) {
    if constexpr (KIND == 1) return (unsigned)(row * 1024 + col) * 2u;
    else return ((unsigned)(col >> 10) * (unsigned)(MT * 1024) + (unsigned)(row * 1024 + (col & 1023))) * 2u;
}
template <int KIND> __device__ __forceinline__ f32x4 epi_quad(const Epi& e, int row, int col, f32x4 a, float mu, float rstd, f32x4 va, f32x4 vb, f32x4 vx) {
    const f32x4 y = epi_val<KIND>(col, a, mu, rstd, va, vb, vx); st_bf4(epi_ptr<KIND>(e, row, col), y); return y;
}
__device__ __forceinline__ f32x4 epi_val2(f32x4 ga, f32x4 ua, float mu, float rstd, f32x4 c1g, f32x4 c2g, f32x4 c1u, f32x4 c2u) {
    const f32x4 g = (ga - c1g * mu) * rstd + c2g;
    const f32x4 u = (ua - c1u * mu) * rstd + c2u;
    return g * sigm4(g) * u;
}
__device__ __forceinline__ void epi_quad2(const Epi& e, int row, int c, f32x4 ga, f32x4 ua, float mu, float rstd, f32x4 c1g, f32x4 c2g, f32x4 c1u, f32x4 c2u) {
    st_bf4(e.o + (size_t)row * DFF + c, epi_val2(ga, ua, mu, rstd, c1g, c2g, c1u, c2u));
}
__device__ __forceinline__ void st_bf8_wt(__amdgpu_buffer_rsrc_t r, unsigned byteoff, f32x4 y0, f32x4 y1) { v4u w; w.x = cvt_pk_bf16(y0[0], y0[1]); w.y = cvt_pk_bf16(y0[2], y0[3]); w.z = cvt_pk_bf16(y1[0], y1[1]); w.w = cvt_pk_bf16(y1[2], y1[3]); st16_wt(r, byteoff, w); }
__device__ __forceinline__ void stat_finish(float s, float q, float& mu, float& rstd) {
    mu = s * (1.0f / 1024.0f); const float var = fmaxf(q * (1.0f / 1024.0f) - mu * mu, 0.f); rstd = rsqrtf(var + LN_EPS);
}
__device__ __forceinline__ void rowstat_full(const float2* part, int row, float& mu, float& rstd) {
    const float4* pp = (const float4*)(part + (size_t)row * 16); float s = 0.f, q = 0.f;
#pragma unroll
    for (int i = 0; i < 8; ++i) { const float4 a = pp[i]; s += a.x + a.z; q += a.y + a.w; }
    stat_finish(s, q, mu, rstd);
}

constexpr int TAB_OFF = 131072 + 64;
template <int KIND> struct BigEpi {
    Epi e;
    __device__ __forceinline__ void operator()(const f32x4 (&acc)[2][2][4][2], const pg8::Unit& u, int wr, int wc, int fr, int fq) const {
        extern __shared__ __attribute__((aligned(16))) unsigned char shm_[];
        const float2* tab = (const float2*)(shm_ + TAB_OFF);
        const __amdgpu_buffer_rsrc_t orsrc = wt_rsrc(e.o);
        int pc0_ = u.pn * 256 + wc * 32 + fq * 8; asm volatile("" : "+v"(pc0_));
        const int pc0 = pc0_;
        f32x4 va[2][2], vb[2][2], vl[2][2];
#pragma unroll
        for (int bj = 0; bj < 2; ++bj)
#pragma unroll
            for (int n = 0; n < 2; ++n) {
                va[bj][n] = *(const f32x4*)(e.a + pc0 + bj * 128 + n * 4); vb[bj][n] = *(const f32x4*)(e.b + pc0 + bj * 128 + n * 4);
                if (KIND == 0 && (u.pn >> 2) == 1) vl[bj][n] = *(const f32x4*)((const float*)e.x + ((pc0 + bj * 128 + n * 4) & 1023)); else vl[bj][n] = (f32x4){0.f, 0.f, 0.f, 0.f};
            }
        constexpr int GR = (KIND == 3) ? 1 : 2;
#pragma unroll
        for (int g4 = 0; g4 < 8 / GR; ++g4) {
            const int ai = (g4 * GR) >> 2, m0 = (g4 * GR) & 3;
            int rowl_ = ai * 128 + wr * 64 + m0 * 16 + fr; asm volatile("" : "+v"(rowl_));
            const int rowl = rowl_, rowb = u.pm * 256 + rowl;
            uint4 zz[GR][2];
            if constexpr (KIND == 1) {
#pragma unroll
                for (int mm = 0; mm < GR; ++mm)
#pragma unroll
                    for (int bj = 0; bj < 2; ++bj) zz[mm][bj] = *(const uint4*)((const bf16_t*)e.x + (size_t)(rowb + mm * 16) * 1024 + pc0 + bj * 128);
                asm volatile("" ::: "memory");
            }
#pragma unroll
            for (int mm = 0; mm < GR; ++mm) {
                const int row = rowb + mm * 16, m = m0 + mm;
                float mu = 0.f, rstd = 1.f;
                if (e.stat) { const float2 ms = tab[rowl + mm * 16]; mu = ms.x; rstd = ms.y; }
                float s = 0.f, q = 0.f;
                if constexpr (KIND == 2) {
                    const f32x4 y0 = epi_val2(acc[ai][0][m][0], acc[ai][1][m][0], mu, rstd, va[0][0], vb[0][0], va[1][0], vb[1][0]);
                    const f32x4 y1 = epi_val2(acc[ai][0][m][1], acc[ai][1][m][1], mu, rstd, va[0][1], vb[0][1], va[1][1], vb[1][1]);
                    st_bf8_wt(orsrc, (unsigned)(row * DFF + u.pn * 128 + wc * 32 + fq * 8) * 2u, y0, y1);
                } else {
#pragma unroll
                    for (int bj = 0; bj < 2; ++bj) {
                        f32x4 x0 = vl[bj][0], x1 = vl[bj][1];
                        if constexpr (KIND == 1) { const uint4 w = zz[mm][bj]; x0 = (f32x4){bf2f(w.x & 0xffffu), bf2f(w.x >> 16), bf2f(w.y & 0xffffu), bf2f(w.y >> 16)}; x1 = (f32x4){bf2f(w.z & 0xffffu), bf2f(w.z >> 16), bf2f(w.w & 0xffffu), bf2f(w.w >> 16)}; }
                        const int col = pc0 + bj * 128;
                        v4u w;
                        { const f32x4 r0 = epi_val<KIND>(col, acc[ai][bj][m][0], mu, rstd, va[bj][0], vb[bj][0], x0);
                          w.x = cvt_pk_bf16(r0[0], r0[1]); w.y = cvt_pk_bf16(r0[2], r0[3]);
                          s += (r0[0] + r0[1]) + (r0[2] + r0[3]); q += (r0[0] * r0[0] + r0[1] * r0[1]) + (r0[2] * r0[2] + r0[3] * r0[3]); }
                        if constexpr (KIND == 3) __builtin_amdgcn_sched_barrier(0);
                        { const f32x4 r1 = epi_val<KIND>(col, acc[ai][bj][m][1], mu, rstd, va[bj][1], vb[bj][1], x1);
                          w.z = cvt_pk_bf16(r1[0], r1[1]); w.w = cvt_pk_bf16(r1[2], r1[3]);
                          s += (r1[0] + r1[1]) + (r1[2] + r1[3]); q += (r1[0] * r1[0] + r1[1] * r1[1]) + (r1[2] * r1[2] + r1[3] * r1[3]); }
                        st16_wt(orsrc, epi_off<KIND>(row, col), w);
                        if constexpr (KIND == 3) __builtin_amdgcn_sched_barrier(0);
                    }
                }
                if constexpr (KIND == 1 || KIND == 3) {
                    s += __shfl_xor(s, 16); s += __shfl_xor(s, 32); q += __shfl_xor(q, 16); q += __shfl_xor(q, 32);
                    if (fq == 0 && (KIND == 1 || u.pn >= 4)) e.opart[(size_t)row * 16 + (u.pn & 3) * 4 + wc] = make_float2(s, q);
                }
            }
            asm volatile("" ::: "memory");
        }
    }
};

template <int KIND> __device__ __forceinline__ void small_gemm(unsigned char* shm, const bf16_t* A, const bf16_t* Bt, int N, int K, const Epi& e) {
    float* red = (float*)shm;
    int tid_ = threadIdx.x; asm volatile("" : "+v"(tid_));
    const int tid = tid_, wid = tid >> 6, lane = tid & 63, fr = lane & 15, fq = lane >> 4;
    const int ncu = (KIND == 2) ? (N / 256) * 4 : N / 64, nunits = ncu * 4;
    const int nb = (KIND == 2) ? 128 : (int)gridDim.x, bi = (int)gridDim.x - 1 - (int)blockIdx.x;
    for (int unit = bi; unit < nunits && bi < nb; unit += nb) {
        const int ru = unit & 3, cu = unit >> 2, r0 = ru * 32;
        int b0, b1, lcol;
        if (KIND == 2) { const int cb = cu >> 2, cq = cu & 3; b0 = cb * 256 + cq * 32; b1 = b0 + 128; lcol = cb * 128 + cq * 32; }
        else { b0 = cu * 64; b1 = b0 + 32; lcol = b0; }
        const int kw = K >> 3, kbeg = wid * kw;
        f32x4 acc[2][2][2];
#pragma unroll
        for (int t = 0; t < 2; ++t)
#pragma unroll
            for (int i = 0; i < 2; ++i)
#pragma unroll
                for (int j = 0; j < 2; ++j) acc[t][i][j] = (f32x4){0.f, 0.f, 0.f, 0.f};
        const int rr = tid >> 4, jj = tid & 15, row = P + r0 + rr;
        float4 sp[8];
        if (e.stat) { const float4* pp = (const float4*)(e.stat + (size_t)row * 16);
#pragma unroll
            for (int i = 0; i < 8; ++i) sp[i] = pp[i]; }
        const int ecol = (KIND == 2) ? (((lcol + (jj & 7) * 4) >> 7) * 256 + ((lcol + (jj & 7) * 4) & 127)) : (lcol + (jj >> 3) * 32 + (jj & 7) * 4);
        const f32x4 pva = *(const f32x4*)(e.a + ecol), pvb = *(const f32x4*)(e.b + ecol);
        f32x4 pvx = (f32x4){0.f, 0.f, 0.f, 0.f}, pvy = pvx;
        if constexpr (KIND == 2) { pvx = *(const f32x4*)(e.a + ecol + 128); pvy = *(const f32x4*)(e.b + ecol + 128); }
        if constexpr (KIND == 0) { if ((ecol >> 10) == 1) pvx = *(const f32x4*)((const float*)e.x + (ecol & 1023)); }
        if constexpr (KIND == 1) pvx = ld_bf4((const bf16_t*)e.x + (size_t)row * 1024 + ecol);
        const bf16_t* ap = A + (size_t)(P + r0 + fr) * K + kbeg + 8 * fq;
        const bf16_t* bp0 = Bt + (size_t)(b0 + fr) * K + kbeg + 8 * fq;
        const bf16_t* bp1 = Bt + (size_t)(b1 + fr) * K + kbeg + 8 * fq;
        const size_t r16 = (size_t)16 * K;
#pragma unroll 4
        for (int kk = 0; kk < kw; kk += 32) {
            const bf16x8 a0 = *(const bf16x8*)(ap + kk), a1 = *(const bf16x8*)(ap + r16 + kk);
            const bf16x8 b00 = *(const bf16x8*)(bp0 + kk), b01 = *(const bf16x8*)(bp0 + r16 + kk), b10 = *(const bf16x8*)(bp1 + kk), b11 = *(const bf16x8*)(bp1 + r16 + kk);
            acc[0][0][0] = __builtin_amdgcn_mfma_f32_16x16x32_bf16(b00, a0, acc[0][0][0], 0, 0, 0);
            acc[0][0][1] = __builtin_amdgcn_mfma_f32_16x16x32_bf16(b01, a0, acc[0][0][1], 0, 0, 0);
            acc[0][1][0] = __builtin_amdgcn_mfma_f32_16x16x32_bf16(b00, a1, acc[0][1][0], 0, 0, 0);
            acc[0][1][1] = __builtin_amdgcn_mfma_f32_16x16x32_bf16(b01, a1, acc[0][1][1], 0, 0, 0);
            acc[1][0][0] = __builtin_amdgcn_mfma_f32_16x16x32_bf16(b10, a0, acc[1][0][0], 0, 0, 0);
            acc[1][0][1] = __builtin_amdgcn_mfma_f32_16x16x32_bf16(b11, a0, acc[1][0][1], 0, 0, 0);
            acc[1][1][0] = __builtin_amdgcn_mfma_f32_16x16x32_bf16(b10, a1, acc[1][1][0], 0, 0, 0);
            acc[1][1][1] = __builtin_amdgcn_mfma_f32_16x16x32_bf16(b11, a1, acc[1][1][1], 0, 0, 0);
        }
#pragma unroll
        for (int t = 0; t < 2; ++t)
#pragma unroll
            for (int i = 0; i < 2; ++i)
#pragma unroll
                for (int j = 0; j < 2; ++j) *(f32x4*)(red + ((wid * 2 + t) * 32 + 16 * i + fr) * 32 + 8 * fq + 4 * j) = acc[t][i][j];
        __syncthreads();
        float mu = 0.f, rstd = 1.f;
        if (e.stat) { float s = 0.f, q = 0.f;
#pragma unroll
            for (int i = 0; i < 8; ++i) { s += sp[i].x + sp[i].z; q += sp[i].y + sp[i].w; }
            stat_finish(s, q, mu, rstd); }
        if constexpr (KIND == 2) {
            if (jj < 8) {
                const int c4 = jj * 4; f32x4 ga = (f32x4){0.f, 0.f, 0.f, 0.f}, ua = ga;
#pragma unroll
                for (int w = 0; w < 8; ++w) { ga += *(const f32x4*)(red + ((w * 2 + 0) * 32 + rr) * 32 + c4); ua += *(const f32x4*)(red + ((w * 2 + 1) * 32 + rr) * 32 + c4); }
                epi_quad2(e, row, lcol + c4, ga, ua, mu, rstd, pva, pvb, pvx, pvy);
            }
        } else {
            const int t = jj >> 3, c4 = (jj & 7) * 4; f32x4 v = (f32x4){0.f, 0.f, 0.f, 0.f};
#pragma unroll
            for (int w = 0; w < 8; ++w) v += *(const f32x4*)(red + ((w * 2 + t) * 32 + rr) * 32 + c4);
            const f32x4 r = epi_quad<KIND>(e, row, ecol, v, mu, rstd, pva, pvb, pvx);
            if constexpr (KIND == 1 || KIND == 3) {
                float s = (r[0] + r[1]) + (r[2] + r[3]), q = (r[0] * r[0] + r[1] * r[1]) + (r[2] * r[2] + r[3] * r[3]);
                s += __shfl_xor(s, 1); s += __shfl_xor(s, 2); s += __shfl_xor(s, 4); s += __shfl_xor(s, 8);
                q += __shfl_xor(q, 1); q += __shfl_xor(q, 2); q += __shfl_xor(q, 4); q += __shfl_xor(q, 8);
                if (jj == 0 && (KIND == 1 || cu >= 16)) e.opart[(size_t)row * 16 + (cu & 15)] = make_float2(s, q);
            }
        }
        __syncthreads();
    }
}

template <int KIND> __device__ __forceinline__ void run_gemm(unsigned char* shm, const pg8::Gemm& g, const Epi& e) {
    pg8::StaticOrder S; S.init(g.M, g.N, (int)gridDim.x, (int)blockIdx.x);
    BigEpi<KIND> E{e};
    if (e.stat) {
        const int c = (int)blockIdx.x, pm = 8 * (c & 7) + ((c >> 3) & 7);
        if (threadIdx.x < 256) { float mu, rstd; rowstat_full(e.stat, pm * 256 + (int)threadIdx.x, mu, rstd); ((float2*)(shm + TAB_OFF))[threadIdx.x] = make_float2(mu, rstd); }
        __syncthreads();
    }
    pg8::gemm_phase((PG8_LAS unsigned char*)shm, g, S, E);
    __syncthreads();
    small_gemm<KIND>(shm, g.A, g.Bt, g.N, g.K, e);
}

struct MatDesc { const float* src; bf16_t* dst; int K, N; const float* gain; const float* bias; float* c1; float* c2; int swiglu; };
__device__ __forceinline__ int mat_tiles(int id) { return id < 2 ? 64 : id < 4 ? 16 : id < 6 ? 32 : id < 8 ? 16 : id < 12 ? 88 : 16; }
__device__ __forceinline__ void get_mat(const Params& p, int id, MatDesc& m) {
    unsigned char* ws = p.ws; m.gain = nullptr; m.bias = nullptr; m.c1 = nullptr; m.c2 = nullptr; m.swiglu = 0;
    if (id < 2) { const int j = id; m.src = p.in[8] + (size_t)j * 1024 * 4096; m.dst = (bf16_t*)(ws + OFF_WT_A_IN) + (size_t)j * 4096 * 1024; m.K = 1024; m.N = 4096;
        if (j > 0) { m.gain = p.in[5] + (2 * j - 1) * 1024; m.bias = p.in[6] + (2 * j - 1) * 1024; }
        m.c1 = (float*)(ws + OFF_C1_A) + j * 4096; m.c2 = (float*)(ws + OFF_C2_A) + j * 4096; }
    else if (id < 4) { const int j = id - 2; m.src = p.in[10] + (size_t)j * 1024 * 1024; m.dst = (bf16_t*)(ws + OFF_WT_A_OUT) + (size_t)j * 1024 * 1024; m.K = 1024; m.N = 1024; }
    else if (id < 6) { const int j = id - 4; m.src = p.in[11] + (size_t)j * 1024 * 2048; m.dst = (bf16_t*)(ws + OFF_WT_B_IN) + (size_t)j * 2048 * 1024; m.K = 1024; m.N = 2048;
        m.gain = p.in[5] + (2 * j) * 1024; m.bias = p.in[6] + (2 * j) * 1024;
        m.c1 = (float*)(ws + OFF_C1_B) + j * 2048; m.c2 = (float*)(ws + OFF_C2_B) + j * 2048; }
    else if (id < 8) { const int j = id - 6; m.src = p.in[16] + (size_t)j * 1024 * 1024; m.dst = (bf16_t*)(ws + OFF_WT_B_OUT) + (size_t)j * 1024 * 1024; m.K = 1024; m.N = 1024; }
    else if (id < 12) { const int l = id - 8; m.src = p.in[17] + (size_t)l * 1024 * 5632; m.dst = (bf16_t*)(ws + OFF_WT_F_IN) + (size_t)l * 5632 * 1024; m.K = 1024; m.N = 5632;
        m.gain = p.in[3] + l * 1024; m.bias = p.in[4] + l * 1024;
        m.c1 = (float*)(ws + OFF_C1_F) + l * 5632; m.c2 = (float*)(ws + OFF_C2_F) + l * 5632; m.swiglu = 1; }
    else { const int l = id - 12; m.src = p.in[18] + (size_t)l * 2816 * 1024; m.dst = (bf16_t*)(ws + OFF_WT_F_OUT) + (size_t)l * 1024 * 2816; m.K = 2816; m.N = 1024; }
}
__device__ __forceinline__ void phase_prep(const Params& p, unsigned char* shm) {
    int tid_ = threadIdx.x; asm volatile("" : "+v"(tid_)); const int tid = tid_;
    unsigned short* tile = (unsigned short*)shm;
    float* red = (float*)(shm + 64 * 264 * 2);
    for (int task = blockIdx.x; task < 672; task += gridDim.x) {
        int id = 0, t = task; while (t >= mat_tiles(id)) { t -= mat_tiles(id); ++id; }
        MatDesc m; get_mat(p, id, m);
        const int n0 = t * 64;
        int nd0 = n0;
        if (m.swiglu) { const int c = n0 < 2816 ? n0 : n0 - 2816; nd0 = (c >> 7) * 256 + (c & 127) + (n0 < 2816 ? 0 : 128); }
        const int kk = tid >> 4, n4 = (tid & 15) * 4;
        float c1a[4] = {0.f, 0.f, 0.f, 0.f}, c2a[4] = {0.f, 0.f, 0.f, 0.f};
        float4 wq[8]; float gq[8], bq[8];
#pragma unroll
        for (int p8 = 0; p8 < 8; ++p8) { const int k = p8 * 32 + kk; wq[p8] = *(const float4*)(m.src + (size_t)k * m.N + n0 + n4); gq[p8] = m.gain ? m.gain[k] : 1.0f; bq[p8] = m.bias ? m.bias[k] : 0.0f; }
        for (int k0 = 0; k0 < m.K; k0 += 256) {
#pragma unroll
            for (int p8 = 0; p8 < 8; ++p8) {
                const float wv[4] = {wq[p8].x, wq[p8].y, wq[p8].z, wq[p8].w};
#pragma unroll
                for (int i = 0; i < 4; ++i) { const unsigned short r = f2bf(wv[i] * gq[p8]); tile[(n4 + i) * 264 + p8 * 32 + kk] = r; c1a[i] += bf2f(r); c2a[i] += bq[p8] * wv[i]; }
            }
            if (k0 + 256 < m.K) {
#pragma unroll
                for (int p8 = 0; p8 < 8; ++p8) { const int k = k0 + 256 + p8 * 32 + kk; wq[p8] = *(const float4*)(m.src + (size_t)k * m.N + n0 + n4); gq[p8] = m.gain ? m.gain[k] : 1.0f; bq[p8] = m.bias ? m.bias[k] : 0.0f; }
            }
            asm volatile("s_waitcnt lgkmcnt(0)" ::: "memory"); __builtin_amdgcn_s_barrier(); asm volatile("" ::: "memory");
            const int n = tid >> 3, cl = n & 31, nrow = (n & 32) + 16 * ((cl >> 2) & 1) + 4 * (cl >> 3) + (cl & 3);
#pragma unroll
            for (int p2 = 0; p2 < 4; ++p2) { const int k8 = (tid & 7) * 8 + p2 * 64; const uint4 v = *(const uint4*)&tile[n * 264 + k8]; *(uint4*)(m.dst + (size_t)(nd0 + nrow) * m.K + k0 + k8) = v; }
            asm volatile("s_waitcnt lgkmcnt(0)" ::: "memory"); __builtin_amdgcn_s_barrier(); asm volatile("" ::: "memory");
        }
        if (m.c1) {
#pragma unroll
            for (int i = 0; i < 4; ++i) { red[(0 * 32 + kk) * 64 + n4 + i] = c1a[i]; red[(1 * 32 + kk) * 64 + n4 + i] = c2a[i]; }
            __syncthreads();
            if (tid < 128) { const int which = tid >> 6, n = tid & 63; float s = 0.f; for (int k2 = 0; k2 < 32; ++k2) s += red[(which * 32 + k2) * 64 + n]; (which ? m.c2 : m.c1)[nd0 + n] = s; }
            __syncthreads();
        }
    }
    bf16_t* X0 = (bf16_t*)(p.ws + OFF_X0);
    for (size_t i = (size_t)blockIdx.x * 512 + tid; i < (size_t)MT * 256; i += (size_t)gridDim.x * 512) {
        const size_t e0 = i * 4; const float* src = e0 < (size_t)P * D ? p.in[0] + e0 : p.in[1] + (e0 - (size_t)P * D);
        st_bf4(X0 + e0, *(const f32x4*)src);
    }
    if (blockIdx.x == 0) {
        float* LB = (float*)(p.ws + OFF_LB);
        for (int c = tid; c < 1024; c += 512) {
            const float r0 = p.in[7][c], r1 = p.in[7][1024 + c], r2 = p.in[7][2048 + c], r3 = p.in[7][3072 + c];
            const float mx = fmaxf(fmaxf(r0, r1), fmaxf(r2, r3));
            const float e0 = expf(r0 - mx), e1 = expf(r1 - mx), e2 = expf(r2 - mx), e3 = expf(r3 - mx);
            LB[c] = 0.f; LB[1024 + c] = (e1 + e2) / (e0 + e1 + e2 + e3);
            float* ONES = (float*)(p.ws + OFF_ONES); ONES[c] = 1.0f; ONES[1024 + c] = 0.0f;
        }
    }
}

__device__ __forceinline__ void unpack8(const uint4 r, float* d) {
    *(float4*)d = make_float4(bf2f(r.x & 0xffffu), bf2f(r.x >> 16), bf2f(r.y & 0xffffu), bf2f(r.y >> 16));
    *(float4*)(d + 4) = make_float4(bf2f(r.z & 0xffffu), bf2f(r.z >> 16), bf2f(r.w & 0xffffu), bf2f(r.w >> 16));
}
__device__ __forceinline__ void phase_hgrn_pre(const Params& p, unsigned char* shm) {
    bf16_t* RAWq = (bf16_t*)shm;
    bf16_t* RAWk = RAWq + 64 * 128;
    bf16_t* Qm = RAWk + 64 * 128;
    bf16_t* Km = Qm + 64 * 136;
    bf16_t* KmT = Km + 64 * 136;
    bf16_t* AmL = KmT + 128 * 72;
    float* tot = (float*)(AmL + 64 * 72);
    bf16_t* Q = (bf16_t*)(p.ws + OFF_Q); const bf16_t* Kb = (const bf16_t*)(p.ws + OFF_K); bf16_t* KT = (bf16_t*)(p.ws + OFF_ZMIX); float* EV = (float*)(p.ws + OFF_STM);
    bf16_t* AM = (bf16_t*)(p.ws + OFF_AM);
    int tid_ = threadIdx.x; asm volatile("" : "+v"(tid_));
    const int tid = tid_, tq = tid >> 7, kcol = tid & 127, lt = tid >> 3, lseg = (tid & 7) * 16, wid = tid >> 6, lane = tid & 63, fr = lane & 15, fq = lane >> 4;
#define PRE_BAR() do { asm volatile("s_waitcnt lgkmcnt(0)" ::: "memory"); __builtin_amdgcn_s_barrier(); asm volatile("" ::: "memory"); } while (0)
    uint4 nq0, nq1, nk0, nk1;
    { const int it0 = (int)blockIdx.x, c0 = it0 & 31, h0 = (it0 >> 5) & 7, b0 = it0 >> 8; const size_t g0 = (size_t)(b0 * 2048 + c0 * 64 + lt) * 1024 + h0 * 128 + lseg;
      nq0 = *(const uint4*)(Q + g0); nq1 = *(const uint4*)(Q + g0 + 8); nk0 = *(const uint4*)(Kb + g0); nk1 = *(const uint4*)(Kb + g0 + 8); }
    for (int item = blockIdx.x; item < 2048; item += gridDim.x) {
        const int c = item & 31, h = (item >> 5) & 7, b = item >> 8;
        const size_t goff = (size_t)(b * 2048 + c * 64 + lt) * 1024 + h * 128 + lseg;
        *(uint4*)(RAWq + lt * 128 + lseg) = nq0; *(uint4*)(RAWq + lt * 128 + lseg + 8) = nq1;
        *(uint4*)(RAWk + lt * 128 + lseg) = nk0; *(uint4*)(RAWk + lt * 128 + lseg + 8) = nk1;
        { const int itn = item + (int)gridDim.x;
          if (itn < 2048) { const int cn = itn & 31, hn = (itn >> 5) & 7, bn = itn >> 8; const size_t gn = (size_t)(bn * 2048 + cn * 64 + lt) * 1024 + hn * 128 + lseg;
            nq0 = *(const uint4*)(Q + gn); nq1 = *(const uint4*)(Q + gn + 8); nk0 = *(const uint4*)(Kb + gn); nk1 = *(const uint4*)(Kb + gn + 8); } }
        PRE_BAR();
        float lf[16], kv[16]; float cs = 0.f;
#pragma unroll
        for (int i = 0; i < 16; ++i) { kv[i] = bf2f(RAWk[(16 * tq + i) * 128 + kcol]); lf[i] = __builtin_amdgcn_logf(fmaxf(1.0f - kv[i], 1e-6f)); cs += lf[i]; }
        tot[tq * 128 + kcol] = cs;
        PRE_BAR();
        {
            const float t0 = tot[kcol], t1 = tot[128 + kcol], t2 = tot[256 + kcol], t3 = tot[384 + kcol];
            float g = (tq > 0 ? t0 : 0.f) + (tq > 1 ? t1 : 0.f) + (tq > 2 ? t2 : 0.f);
            const float gmid = t0 + t1;
            if (tq == 0) { float* ev = EV + (size_t)(b * 32 + c) * 1024 + h * 128 + kcol; ev[0] = __builtin_amdgcn_exp2f(gmid); ev[262144] = __builtin_amdgcn_exp2f(t2 + t3); }
            unsigned kmt[8];
#pragma unroll
            for (int i = 0; i < 16; i += 2) {
                const int t = 16 * tq + i;
                const float ga = g + lf[i], gb = ga + lf[i + 1]; g = gb;
                const float qa = bf2f(RAWq[t * 128 + kcol]), qb = bf2f(RAWq[(t + 1) * 128 + kcol]);
                const unsigned pq = cvt_pk_bf16(qa * __builtin_amdgcn_exp2f(fminf(ga - gmid, 126.f)), qb * __builtin_amdgcn_exp2f(fminf(gb - gmid, 126.f)));
                const unsigned pk = cvt_pk_bf16(kv[i] * __builtin_amdgcn_exp2f(fminf(gmid - ga, 126.f)), kv[i + 1] * __builtin_amdgcn_exp2f(fminf(gmid - gb, 126.f)));
                Qm[t * 136 + kcol] = (bf16_t)(pq & 0xffffu); Qm[(t + 1) * 136 + kcol] = (bf16_t)(pq >> 16);
                Km[t * 136 + kcol] = (bf16_t)(pk & 0xffffu); Km[(t + 1) * 136 + kcol] = (bf16_t)(pk >> 16);
                kmt[i >> 1] = pk;
            }
            *(uint4*)(KmT + kcol * 72 + 16 * tq) = make_uint4(kmt[0], kmt[1], kmt[2], kmt[3]);
            *(uint4*)(KmT + kcol * 72 + 16 * tq + 8) = make_uint4(kmt[4], kmt[5], kmt[6], kmt[7]);
        }
        PRE_BAR();
#pragma unroll
        for (int hf = 0; hf < 2; ++hf) {
            const int idx = wid + 8 * hf, tt = idx >> 2, st = idx & 3;
            f32x4 a = (f32x4){0.f, 0.f, 0.f, 0.f};
            if (st <= tt) {
#pragma unroll
                for (int k4 = 0; k4 < 4; ++k4) {
                    const bf16x8 X = *(const bf16x8*)(Km + (16 * st + fr) * 136 + 32 * k4 + 8 * fq), Y = *(const bf16x8*)(Qm + (16 * tt + fr) * 136 + 32 * k4 + 8 * fq);
                    a = __builtin_amdgcn_mfma_f32_16x16x32_bf16(X, Y, a, 0, 0, 0);
                }
            }
            const int t = 16 * tt + fr;
#pragma unroll
            for (int r = 0; r < 4; ++r) if (16 * st + 4 * fq + r > t) a[r] = 0.f;
            st_bf4(AmL + t * 72 + 16 * st + 4 * fq, a);
        }
        PRE_BAR();
        *(uint4*)(Q + goff) = *(const uint4*)(Qm + lt * 136 + lseg); *(uint4*)(Q + goff + 8) = *(const uint4*)(Qm + lt * 136 + lseg + 8);
        { const int kk = tid >> 2, sg = (tid & 3) * 16; bf16_t* dst = KT + (size_t)item * 8192 + kk * 64 + sg;
          *(uint4*)dst = *(const uint4*)(KmT + kk * 72 + sg); *(uint4*)(dst + 8) = *(const uint4*)(KmT + kk * 72 + sg + 8); }
        *(uint4*)(AM + (size_t)item * 4096 + lt * 64 + (tid & 7) * 8) = *(const uint4*)(AmL + lt * 72 + (tid & 7) * 8);
        PRE_BAR();
    }
#undef PRE_BAR
}
__device__ __forceinline__ void phase_hgrn_prompt(const Params& p, unsigned char* shm, int j) {
    constexpr int SET = 64 * 136 + 128 * 72 + 64 * 72 + 32 * 72 + 32 * 136;
    const bf16_t* Q = (const bf16_t*)(p.ws + OFF_Q); const bf16_t* Vb = (const bf16_t*)(p.ws + OFF_V);
    const bf16_t* KT = (const bf16_t*)(p.ws + OFF_ZMIX); const float* EV = (const float*)(p.ws + OFF_STM); const bf16_t* AM = (const bf16_t*)(p.ws + OFF_AM);
    float* ORAW = (float*)(p.ws + OFF_H);
    int tid_ = threadIdx.x; asm volatile("" : "+v"(tid_));
    const int tid = tid_, wid = tid >> 6, lane = tid & 63, fr = lane & 15, fq = lane >> 4;
    const int lt = tid >> 3, lseg = (tid & 7) * 16, kk = tid >> 2, sg = (tid & 3) * 16, ks4 = 16 * wid + 4 * fq;
    for (int task = blockIdx.x; task < 256; task += gridDim.x) {
        const int bh = (task & 7) * 8 + (task >> 5), vq = (task >> 3) & 3, b = bh >> 3, h = bh & 7, rowbase = b * 2048;
        f32x4 S[2]; S[0] = (f32x4){0.f, 0.f, 0.f, 0.f}; S[1] = S[0];
        uint4 RA_q0, RA_q1, RA_t0, RA_t1, RA_a, RA_v = make_uint4(0, 0, 0, 0), RB_q0, RB_q1, RB_t0, RB_t1, RB_a, RB_v = make_uint4(0, 0, 0, 0);
        f32x4 RA_em, RA_ee, RB_em, RB_ee;
#define HG_LOAD(cc, R) do { \
            const size_t off = (size_t)(rowbase + (cc) * 64 + lt) * 1024 + h * 128 + lseg; \
            R##_q0 = *(const uint4*)(Q + off); R##_q1 = *(const uint4*)(Q + off + 8); \
            const bf16_t* kt = KT + (size_t)(bh * 32 + (cc)) * 8192 + kk * 64 + sg; R##_t0 = *(const uint4*)kt; R##_t1 = *(const uint4*)(kt + 8); \
            R##_a = *(const uint4*)(AM + (size_t)(bh * 32 + (cc)) * 4096 + lt * 64 + (tid & 7) * 8); \
            if (tid < 256) R##_v = *(const uint4*)(Vb + (size_t)(rowbase + (cc) * 64 + (tid >> 2)) * 1024 + h * 128 + vq * 32 + (tid & 3) * 8); \
            const float* ev = EV + (size_t)(b * 32 + (cc)) * 1024 + h * 128 + ks4; R##_em = *(const f32x4*)ev; R##_ee = *(const f32x4*)(ev + 262144); \
} while (0)
#define HG_BODY(c, R) do { \
            bf16_t* Qm = (bf16_t*)shm + ((c) & 1) * SET; bf16_t* KmT = Qm + 64 * 136; bf16_t* Am = KmT + 128 * 72; bf16_t* VT = Am + 64 * 72; bf16_t* SpT = VT + 32 * 72; \
            *(uint4*)(Qm + lt * 136 + lseg) = R##_q0; *(uint4*)(Qm + lt * 136 + lseg + 8) = R##_q1; \
            *(uint4*)(KmT + kk * 72 + sg) = R##_t0; *(uint4*)(KmT + kk * 72 + sg + 8) = R##_t1; \
            *(uint4*)(Am + lt * 72 + (tid & 7) * 8) = R##_a; \
            if (tid < 256) { const int t = tid >> 2, c8 = (tid & 3) * 8; const unsigned w[4] = {R##_v.x, R##_v.y, R##_v.z, R##_v.w}; \
_Pragma("unroll") \
                for (int i = 0; i < 4; ++i) { VT[(c8 + 2 * i) * 72 + t] = (bf16_t)(w[i] & 0xffffu); VT[(c8 + 2 * i + 1) * 72 + t] = (bf16_t)(w[i] >> 16); } } \
            const f32x4 e_mid = R##_em, e_em = R##_ee, e_end = R##_em * R##_ee; \
_Pragma("unroll") \
            for (int it = 0; it < 2; ++it) { \
                st_bf4(SpT + (16 * it + fr) * 136 + ks4, e_mid * S[it]); } \
            asm volatile("s_waitcnt lgkmcnt(0)" ::: "memory"); __builtin_amdgcn_s_barrier(); asm volatile("" ::: "memory"); \
            if ((c) + 2 < 32) HG_LOAD(((c)) + 2, R); \
              \
            const int it = wid >> 2, tt = wid & 3; \
            bf16x8 YQ[4], XO[4], XS0[2], XS1[2], YS[2], YA[2]; \
_Pragma("unroll") \
            for (int k4 = 0; k4 < 4; ++k4) { \
                YQ[k4] = *(const bf16x8*)(Qm + (16 * tt + fr) * 136 + 32 * k4 + 8 * fq); XO[k4] = *(const bf16x8*)(SpT + (16 * it + fr) * 136 + 32 * k4 + 8 * fq); } \
_Pragma("unroll") \
            for (int k2 = 0; k2 < 2; ++k2) { XS0[k2] = *(const bf16x8*)(VT + (fr) * 72 + 32 * k2 + 8 * fq); XS1[k2] = *(const bf16x8*)(VT + (16 + fr) * 72 + 32 * k2 + 8 * fq); \
                YS[k2] = *(const bf16x8*)(KmT + (16 * wid + fr) * 72 + 32 * k2 + 8 * fq); YA[k2] = *(const bf16x8*)(Am + (16 * tt + fr) * 72 + 32 * k2 + 8 * fq); } \
            f32x4 o = (f32x4){0.f, 0.f, 0.f, 0.f}, d0 = o, d1 = o; \
_Pragma("unroll") \
            for (int k4 = 0; k4 < 4; ++k4) { \
                o = __builtin_amdgcn_mfma_f32_16x16x32_bf16(XO[k4], YQ[k4], o, 0, 0, 0); \
                if (k4 < 2) { d0 = __builtin_amdgcn_mfma_f32_16x16x32_bf16(YS[k4], XS0[k4], d0, 0, 0, 0); d1 = __builtin_amdgcn_mfma_f32_16x16x32_bf16(YS[k4], XS1[k4], d1, 0, 0, 0); \
                              o = __builtin_amdgcn_mfma_f32_16x16x32_bf16(it ? XS1[k4] : XS0[k4], YA[k4], o, 0, 0, 0); } } \
            S[0] = S[0] * e_end + d0 * e_em; S[1] = S[1] * e_end + d1 * e_em; \
            *(f32x4*)(ORAW + (size_t)(rowbase + (c) * 64 + 16 * tt + fr) * 1024 + h * 128 + vq * 32 + 16 * it + 4 * fq) = o; \
} while (0)
        HG_LOAD(0, RA); HG_LOAD(1, RB);
#pragma nounroll
        for (int c = 0; c < 32; c += 2) { const int c1 = c + 1; HG_BODY(c, RA); HG_BODY(c1, RB); }
#undef HG_LOAD
#undef HG_BODY
        float* so = p.out + OUT_HSP + ((size_t)((j * 8 + b) * 8 + h) * 128) * 128;
#pragma unroll
        for (int i2 = 0; i2 < 2; ++i2)
#pragma unroll
            for (int r = 0; r < 4; ++r) so[(size_t)(ks4 + r) * 128 + vq * 32 + 16 * i2 + fr] = S[i2][r];
        __syncthreads();
    }
}
__device__ __forceinline__ void phase_hgrn_sample(const Params& p, unsigned char* shm, int j) {
    float* qs = (float*)shm; float* ks = qs + 128; float* red = ks + 128; float* ssq = red + 16 * 128;
    const bf16_t* Q = (const bf16_t*)(p.ws + OFF_Q); const bf16_t* Kb = (const bf16_t*)(p.ws + OFF_K); const bf16_t* Vb = (const bf16_t*)(p.ws + OFF_V); const bf16_t* G = (const bf16_t*)(p.ws + OFF_G);
    bf16_t* O = (bf16_t*)(p.ws + OFF_O);
    int tid_ = threadIdx.x; asm volatile("" : "+v"(tid_));
    const int tid = tid_, c4 = (tid & 31) * 4, kr = tid >> 5;
    for (int task = blockIdx.x; task < 1024; task += gridDim.x) {
        const int b = task >> 3, h = task & 7; const size_t rowoff = (size_t)(P + b) * 1024 + h * 128;
        if (tid < 128) { qs[tid] = bf2f(Q[rowoff + tid]); ks[tid] = bf2f(Kb[rowoff + tid]); }
        const f32x4 v4 = ld_bf4(Vb + rowoff + c4);
        __syncthreads();
        const float* Sin = p.in[2] + ((size_t)(j * 128 + b) * 8 + h) * 16384; float* Sout = p.out + OUT_HSS + ((size_t)(j * 128 + b) * 8 + h) * 16384;
        f32x4 o4 = (f32x4){0.f, 0.f, 0.f, 0.f};
#pragma unroll
        for (int i = 0; i < 8; ++i) { const int k = kr + 16 * i; f32x4 s = *(const f32x4*)(Sin + k * 128 + c4); s = s + (v4 - s) * ks[k]; *(f32x4*)(Sout + k * 128 + c4) = s; o4 += s * qs[k]; }
        *(f32x4*)(red + kr * 128 + c4) = o4;
        __syncthreads();
        float o = 0.f;
        if (tid < 128) {
#pragma unroll
            for (int r = 0; r < 16; ++r) o += red[r * 128 + tid];
            float ss = o * o;
#pragma unroll
            for (int off = 1; off < 64; off <<= 1) ss += __shfl_xor(ss, off);
            if ((tid & 63) == 0) ssq[tid >> 6] = ss;
        }
        __syncthreads();
        if (tid < 128) {
            const float r = rsqrtf((ssq[0] + ssq[1]) * (1.0f / 128.0f) + RMS_EPS);
            O[rowoff + tid] = f2bf(o * r * p.in[9][j * 128 + tid] * bf2f(G[rowoff + tid]));
        }
        __syncthreads();
    }
}
__device__ __forceinline__ void phase_rms(const Params& p, int j) {
    const float* ORAW = (const float*)(p.ws + OFF_H); const bf16_t* G = (const bf16_t*)(p.ws + OFF_G); bf16_t* O = (bf16_t*)(p.ws + OFF_O);
    int tid_ = threadIdx.x; asm volatile("" : "+v"(tid_)); const int tid = tid_;
    const f32x4 ng = *(const f32x4*)(p.in[9] + j * 128 + (tid & 31) * 4);
    for (int it = blockIdx.x; it < P * 8 / 16; it += gridDim.x) {
        const int pair = it * 16 + (tid >> 5), row = pair >> 3, h = pair & 7; const size_t off = (size_t)row * 1024 + h * 128 + (tid & 31) * 4;
        const f32x4 o4 = *(const f32x4*)(ORAW + off);
        float ss = (o4[0] * o4[0] + o4[1] * o4[1]) + (o4[2] * o4[2] + o4[3] * o4[3]);
#pragma unroll
        for (int o = 1; o < 32; o <<= 1) ss += __shfl_xor(ss, o);
        const float r = rsqrtf(ss * (1.0f / 128.0f) + RMS_EPS);
        st_bf4(O + off, o4 * r * ng * ld_bf4(G + off));
    }
}

__device__ __forceinline__ void phase_spatial(const Params& p, unsigned char* shm, int jb) {
    bf16_t* vnT = (bf16_t*)shm;
    float2* st = (float2*)(shm + 128 * 136 * 2);
    const bf16_t* U = (const bf16_t*)(p.ws + OFF_Q); const bf16_t* Vb = (const bf16_t*)(p.ws + OFF_K); bf16_t* O = (bf16_t*)(p.ws + OFF_O);
    const float2* STV = (const float2*)(p.ws + OFF_STV);
    const float* lng = p.in[12] + jb * 1024; const float* lnb = p.in[13] + jb * 1024; const float* wsp = p.in[14] + (size_t)jb * 8 * 128 * 128; const float* bsp = p.in[15] + jb * 8 * 128;
    float* cvp = p.out + OUT_CVP + (size_t)jb * 8 * 128 * 1024;
    int tid_ = threadIdx.x; asm volatile("" : "+v"(tid_));
    const int tid = tid_, wid = tid >> 6, lane = tid & 63, fr = lane & 15, fq = lane >> 4;
    for (int task = blockIdx.x; task < 256; task += gridDim.x) {
        const int gh = task & 1, cn = task >> 1, b = cn >> 4, n = cn & 15, r0 = b * 2048 + n * 128;
        if (tid < 128) { float mu, rstd; rowstat_full(STV, r0 + tid, mu, rstd); st[tid] = make_float2(mu, rstd); }
        __syncthreads();
        for (int gi = 0; gi < 4; ++gi) {
            const int g = gh * 4 + gi, c0 = g * 128;
            for (int item = tid; item < 1024; item += 512) {
                const int c = (item & 63) * 2, s8 = (item >> 6) * 8;
                const float g0 = lng[c0 + c], g1 = lng[c0 + c + 1], b0 = lnb[c0 + c], b1 = lnb[c0 + c + 1];
                unsigned w0[4], w1[4];
#pragma unroll
                for (int s2 = 0; s2 < 4; ++s2) {
                    float a0[2], a1[2];
#pragma unroll
                    for (int e = 0; e < 2; ++e) {
                        const int s = s8 + s2 * 2 + e; const unsigned vv = *(const unsigned*)(Vb + (size_t)(r0 + s) * 1024 + c0 + c); const float2 ms = st[s];
                        a0[e] = (bf2f(vv & 0xffffu) - ms.x) * ms.y * g0 + b0; a1[e] = (bf2f(vv >> 16) - ms.x) * ms.y * g1 + b1;
                        if (n == 15) *(float2*)(cvp + ((size_t)(b * 128 + s)) * 1024 + c0 + c) = make_float2(a0[e], a1[e]);
                    }
                    w0[s2] = cvt_pk_bf16(a0[0], a0[1]); w1[s2] = cvt_pk_bf16(a1[0], a1[1]);
                }
                *(uint4*)(vnT + c * 136 + s8) = make_uint4(w0[0], w0[1], w0[2], w0[3]);
                *(uint4*)(vnT + (c + 1) * 136 + s8) = make_uint4(w1[0], w1[1], w1[2], w1[3]);
            }
            __syncthreads();
            const int t = 16 * wid + fr;
            f32x4 acc[8];
#pragma unroll
            for (int ct = 0; ct < 8; ++ct) acc[ct] = (f32x4){0.f, 0.f, 0.f, 0.f};
            for (int ks = 0; ks <= (wid >> 1); ++ks) {
                const float* wp = wsp + ((size_t)g * 128 + t) * 128 + 32 * ks + 8 * fq;
                const float4 wa = *(const float4*)wp, wb = *(const float4*)(wp + 4);
                const float wv[8] = {wa.x, wa.y, wa.z, wa.w, wb.x, wb.y, wb.z, wb.w};
                const int sb = 32 * ks + 8 * fq;
                bf16x8 af;
#pragma unroll
                for (int i = 0; i < 8; ++i) af[i] = (short)f2bf((sb + i) <= t ? wv[i] : 0.f);
#pragma unroll
                for (int ct = 0; ct < 8; ++ct) {
                    const bf16x8 bfv = *(const bf16x8*)(vnT + (16 * ct + fr) * 136 + 32 * ks + 8 * fq);
                    acc[ct] = __builtin_amdgcn_mfma_f32_16x16x32_bf16(bfv, af, acc[ct], 0, 0, 0);
                }
            }
            const float bias = bsp[g * 128 + t];
#pragma unroll
            for (int ct = 0; ct < 8; ++ct) {
                const size_t off = (size_t)(r0 + t) * 1024 + c0 + 16 * ct + 4 * fq;
                st_bf4(O + off, ld_bf4(U + off) * (acc[ct] + bias));
            }
            __syncthreads();
        }
    }
    if (blockIdx.x < SR) {
        const int i = blockIdx.x, row = P + i; float mu, rstd; rowstat_full(STV, row, mu, rstd);
        float* cvs = p.out + OUT_CVS + (size_t)jb * 128 * 1024 + (size_t)i * 1024;
        const int c = tid * 2, g = c >> 7;
        const unsigned vv = *(const unsigned*)(Vb + (size_t)row * 1024 + c), uu = *(const unsigned*)(U + (size_t)row * 1024 + c);
        const float n0 = (bf2f(vv & 0xffffu) - mu) * rstd * lng[c] + lnb[c], n1 = (bf2f(vv >> 16) - mu) * rstd * lng[c + 1] + lnb[c + 1];
        *(float2*)(cvs + c) = make_float2(n0, n1);
        const float w00 = wsp[(size_t)g * 128 * 128], bb = bsp[g * 128];
        *(unsigned*)(O + (size_t)row * 1024 + c) = cvt_pk_bf16(bf2f(uu & 0xffffu) * (w00 * n0 + bb), bf2f(uu >> 16) * (w00 * n1 + bb));
    }
}

__device__ __forceinline__ void phase_ln_mat(const Params& p, size_t zoff, size_t stoff, const float* g, const float* bb, int nb) {
    const bf16_t* Z = (const bf16_t*)(p.ws + zoff); const float2* ST = (const float2*)(p.ws + stoff); bf16_t* X = (bf16_t*)(p.ws + OFF_X0);
    int tid_ = threadIdx.x; asm volatile("" : "+v"(tid_));
    const int tid = tid_, wid = tid >> 6, lane = tid & 63, bi = (int)gridDim.x - 1 - (int)blockIdx.x;
    if (bi >= nb) return;
    const int c0 = lane * 8;
    const f32x4 g0 = *(const f32x4*)(g + c0), g1 = *(const f32x4*)(g + c0 + 4), g2 = *(const f32x4*)(g + 512 + c0), g3 = *(const f32x4*)(g + 512 + c0 + 4);
    const f32x4 b0 = *(const f32x4*)(bb + c0), b1 = *(const f32x4*)(bb + c0 + 4), b2 = *(const f32x4*)(bb + 512 + c0), b3 = *(const f32x4*)(bb + 512 + c0 + 4);
    for (int row0 = (bi * 8 + wid) * 2; row0 < MT; row0 += nb * 16) {
        float2 pr[2]; uint4 za[2], zb[2];
#pragma unroll
        for (int r = 0; r < 2; ++r) { const int row = row0 + r;
            pr[r] = ST[(size_t)row * 16 + (lane & 15)]; za[r] = *(const uint4*)(Z + (size_t)row * 1024 + c0); zb[r] = *(const uint4*)(Z + (size_t)row * 1024 + 512 + c0); }
#pragma unroll
        for (int r = 0; r < 2; ++r) { const int row = row0 + r;
            float s = pr[r].x, q = pr[r].y;
#pragma unroll
            for (int o = 1; o < 16; o <<= 1) { s += __shfl_xor(s, o); q += __shfl_xor(q, o); }
            float mu, rstd; stat_finish(s, q, mu, rstd);
            const f32x4 z0 = (f32x4){bf2f(za[r].x & 0xffffu), bf2f(za[r].x >> 16), bf2f(za[r].y & 0xffffu), bf2f(za[r].y >> 16)}, z1 = (f32x4){bf2f(za[r].z & 0xffffu), bf2f(za[r].z >> 16), bf2f(za[r].w & 0xffffu), bf2f(za[r].w >> 16)};
            const f32x4 z2 = (f32x4){bf2f(zb[r].x & 0xffffu), bf2f(zb[r].x >> 16), bf2f(zb[r].y & 0xffffu), bf2f(zb[r].y >> 16)}, z3 = (f32x4){bf2f(zb[r].z & 0xffffu), bf2f(zb[r].z >> 16), bf2f(zb[r].w & 0xffffu), bf2f(zb[r].w >> 16)};
            const f32x4 x0 = (z0 - mu) * rstd * g0 + b0, x1 = (z1 - mu) * rstd * g1 + b1, x2 = (z2 - mu) * rstd * g2 + b2, x3 = (z3 - mu) * rstd * g3 + b3;
            uint4 w0, w1; w0.x = cvt_pk_bf16(x0[0], x0[1]); w0.y = cvt_pk_bf16(x0[2], x0[3]); w0.z = cvt_pk_bf16(x1[0], x1[1]); w0.w = cvt_pk_bf16(x1[2], x1[3]);
            w1.x = cvt_pk_bf16(x2[0], x2[1]); w1.y = cvt_pk_bf16(x2[2], x2[3]); w1.z = cvt_pk_bf16(x3[0], x3[1]); w1.w = cvt_pk_bf16(x3[2], x3[3]);
            *(uint4*)(X + (size_t)row * 1024 + c0) = w0; *(uint4*)(X + (size_t)row * 1024 + 512 + c0) = w1;
        }
    }
}

__device__ __forceinline__ void phase_final(const Params& p) {
    const bf16_t* Z = (const bf16_t*)(p.ws + OFF_ZFFN); const float2* STF = (const float2*)(p.ws + OFF_STF);
    const float* g = p.in[5] + 3 * 1024; const float* bb = p.in[6] + 3 * 1024;
    int tid_ = threadIdx.x; asm volatile("" : "+v"(tid_));
    const int tid = tid_, wid = tid >> 6, lane = tid & 63;
    for (int row = blockIdx.x * 8 + wid; row < MT; row += gridDim.x * 8) {
        float s = 0.f, q = 0.f;
        if (lane < 16) { const float2 pr = STF[(size_t)row * 16 + lane]; s = pr.x; q = pr.y; }
#pragma unroll
        for (int o = 1; o < 16; o <<= 1) { s += __shfl_xor(s, o); q += __shfl_xor(q, o); }
        s = __shfl(s, 0); q = __shfl(q, 0);
        float mu, rstd; stat_finish(s, q, mu, rstd);
#pragma unroll
        for (int hf = 0; hf < 2; ++hf) {
            const int c = hf * 512 + lane * 8; const uint4 z8 = *(const uint4*)(Z + (size_t)row * 1024 + c);
            const f32x4 za = (f32x4){bf2f(z8.x & 0xffffu), bf2f(z8.x >> 16), bf2f(z8.y & 0xffffu), bf2f(z8.y >> 16)}, zb = (f32x4){bf2f(z8.z & 0xffffu), bf2f(z8.z >> 16), bf2f(z8.w & 0xffffu), bf2f(z8.w >> 16)};
            float* o = p.out + (size_t)row * 1024 + c;
            *(f32x4*)o = (za - mu) * rstd * *(const f32x4*)(g + c) + *(const f32x4*)(bb + c);
            *(f32x4*)(o + 4) = (zb - mu) * rstd * *(const f32x4*)(g + c + 4) + *(const f32x4*)(bb + c + 4);
        }
    }
}

#define XB_TMO      128
#define XB_XCNT(j)  (256  + 64 * (j))
#define XB_XSUB(j)  (1280 + 64 * (j))
#define XB_XGEN(j)  (2304 + 64 * (j))
#define XB_TOP      3328
#define XB_TOPGEN   3392
#define XCD_BAR_WORDS 3456
#define XB_SPIN_CAP (1u << 18)

__device__ __forceinline__ unsigned xb_ld(unsigned* p)              { return __hip_atomic_load(p, __ATOMIC_RELAXED, __HIP_MEMORY_SCOPE_AGENT); }
__device__ __forceinline__ unsigned xb_add(unsigned* p, unsigned v) { return __hip_atomic_fetch_add(p, v, __ATOMIC_RELAXED, __HIP_MEMORY_SCOPE_AGENT); }
__device__ __forceinline__ unsigned xb_xcc_id() { return (unsigned)__builtin_amdgcn_s_getreg((3 << 11) | 20) & 0xFu; }
#define XB_SPIN(cond, bar) do { unsigned _sp = 0; while (cond) { __builtin_amdgcn_s_sleep(1); \
    if ((++_sp & 255u) == 0u) { if (xb_ld(&(bar)[XB_TMO])) break; if (_sp > XB_SPIN_CAP) { atomicAdd(&(bar)[XB_TMO], 1u); break; } } } } while (0)

struct XcdBarrier {
    unsigned* bar; unsigned x;
    volatile PG8_LAS unsigned* st;
};

__device__ __forceinline__ XcdBarrier xcd_barrier_post(unsigned* bar, volatile PG8_LAS unsigned* st) {
    XcdBarrier b; b.bar = bar; b.x = xb_xcc_id(); b.st = st;
    if (threadIdx.x == 0) (void)xb_add(&bar[XB_XCNT(b.x)], 1u);
    return b;
}
__device__ __forceinline__ void xcd_barrier_complete(unsigned* bar, unsigned x, unsigned& nloc, unsigned& nx) {
    const unsigned G = gridDim.x * gridDim.y * gridDim.z;
    unsigned sum, cnt, mine, sp = 0u;
    for (;;) {
        sum = 0u; cnt = 0u; mine = 0u;
#pragma unroll
        for (unsigned j = 0; j < 16; ++j) { const unsigned c = xb_ld(&bar[XB_XCNT(j)]); sum += c; cnt += (c > 0u) ? 1u : 0u; mine = (j == x) ? c : mine; }
        if (sum == G) break;
        __builtin_amdgcn_s_sleep(1);
        if ((++sp & 255u) == 0u) { if (xb_ld(&bar[XB_TMO])) break; if (sp > XB_SPIN_CAP) { atomicAdd(&bar[XB_TMO], 1u); break; } }
    }
    nloc = mine > 0u ? mine : 1u; nx = cnt > 0u ? cnt : 1u;
}

__device__ __forceinline__ void xcd_barrier(const XcdBarrier& b) {
    asm volatile("s_waitcnt vmcnt(0)" ::: "memory");
    __syncthreads();
    if (threadIdx.x == 0) {
        unsigned* bar = b.bar;
        __builtin_amdgcn_s_waitcnt(0);
        unsigned nloc = b.st[0], nx = b.st[1];
        if (nloc == 0u) { xcd_barrier_complete(bar, b.x, nloc, nx); b.st[0] = nloc; b.st[1] = nx; }
        const unsigned old = xb_add(&bar[XB_XSUB(b.x)], 1u);
        const unsigned gen = old / nloc;
        if (old + 1u == (gen + 1u) * nloc) {
            __builtin_amdgcn_fence(__ATOMIC_RELEASE, "agent");
            asm volatile("s_waitcnt vmcnt(0)" ::: "memory");
            const unsigned og = xb_add(&bar[XB_TOP], 1u);
            const unsigned tg = og / nx;
            if (og + 1u == (tg + 1u) * nx) xb_add(&bar[XB_TOPGEN], 1u);
            else XB_SPIN(xb_ld(&bar[XB_TOPGEN]) == tg, bar);
            __builtin_amdgcn_fence(__ATOMIC_ACQUIRE, "agent");
            xb_add(&bar[XB_XGEN(b.x)], 1u);
            asm volatile("s_waitcnt vmcnt(0)" ::: "memory");
        } else {
            XB_SPIN(xb_ld(&bar[XB_XGEN(b.x)]) == gen, bar);
            __builtin_amdgcn_fence(__ATOMIC_ACQUIRE, "agent");
            asm volatile("s_waitcnt vmcnt(0)" ::: "memory");
        }
    }
    __syncthreads();
}

__global__ void __launch_bounds__(512, 2) hgrn2_chunkmlp_mega(Params p) {
    extern __shared__ __attribute__((aligned(16))) unsigned char shm[];
    cg::grid_group grid = cg::this_grid();
#define WSL(name) unsigned char* name = p.ws; asm volatile("" : "+s"(name))
    unsigned* xb_st = (unsigned*)(shm + 131072);
    if (threadIdx.x < 2) xb_st[threadIdx.x] = 0u;
    if (p.out == nullptr) grid.sync();
    const XcdBarrier xbar = xcd_barrier_post((unsigned*)(p.ws + OFF_BAR), (volatile PG8_LAS unsigned*)xb_st);
    phase_prep(p, shm);
    xcd_barrier(xbar);
#define GRID_SYNC() xcd_barrier(xbar)
#pragma nounroll
    for (int l = 0; l < 4; ++l) {
        const int j = l >> 1;
        if ((l & 1) == 0) {
            WSL(ws);
            pg8::Gemm g; g.A = (const bf16_t*)(ws + (l == 0 ? OFF_X0 : OFF_ZFFN)); g.Bt = (const bf16_t*)(ws + OFF_WT_A_IN) + (size_t)j * 4096 * 1024; g.M = P; g.N = 4096; g.K = 1024;
            Epi e{}; e.stat = l == 0 ? nullptr : (const float2*)(ws + OFF_STF); e.a = (const float*)(ws + OFF_C1_A) + j * 4096; e.b = (const float*)(ws + OFF_C2_A) + j * 4096;
            e.o = (bf16_t*)(ws + OFF_Q); e.x = (const float*)(ws + OFF_LB) + j * 1024;
            run_gemm<0>(shm, g, e);
            GRID_SYNC();
            phase_hgrn_pre(p, shm);
            GRID_SYNC();
            phase_hgrn_prompt(p, shm, j);
            phase_hgrn_sample(p, shm, j);
            GRID_SYNC();
            phase_rms(p, j);
            GRID_SYNC();
        } else {
            WSL(ws);
            pg8::Gemm g; g.A = (const bf16_t*)(ws + OFF_ZFFN); g.Bt = (const bf16_t*)(ws + OFF_WT_B_IN) + (size_t)j * 2048 * 1024; g.M = P; g.N = 2048; g.K = 1024;
            Epi e{}; e.stat = (const float2*)(ws + OFF_STF); e.a = (const float*)(ws + OFF_C1_B) + j * 2048; e.b = (const float*)(ws + OFF_C2_B) + j * 2048;
            e.o = (bf16_t*)(ws + OFF_Q); e.opart = (float2*)(ws + OFF_STV);
            run_gemm<3>(shm, g, e);
            GRID_SYNC();
            phase_spatial(p, shm, j);
            GRID_SYNC();
        }
#pragma nounroll
        for (int r = 0; r < 2; ++r) {
            if (r == 1) {
                WSL(ws);
                pg8::Gemm g; g.A = (const bf16_t*)(ws + OFF_ZMIX); g.Bt = (const bf16_t*)(ws + OFF_WT_F_IN) + (size_t)l * 5632 * 1024; g.M = P; g.N = 5632; g.K = 1024;
                Epi e{}; e.stat = (const float2*)(ws + OFF_STM); e.a = (const float*)(ws + OFF_C1_F) + l * 5632; e.b = (const float*)(ws + OFF_C2_F) + l * 5632; e.o = (bf16_t*)(ws + OFF_H);
                run_gemm<2>(shm, g, e);
                GRID_SYNC();
            }
            WSL(ws);
            pg8::Gemm g; Epi e{}; g.M = P; g.N = 1024;
            if (r == 0) {
                g.A = (const bf16_t*)(ws + OFF_O); g.Bt = (const bf16_t*)(ws + ((l & 1) ? OFF_WT_B_OUT : OFF_WT_A_OUT)) + (size_t)j * 1024 * 1024; g.K = 1024;
                if (l == 0) { e.x = ws + OFF_X0; e.a = (const float*)(ws + OFF_ONES); e.b = (const float*)(ws + OFF_ONES) + 1024; }
                else { e.x = ws + OFF_ZFFN; e.stat = (const float2*)(ws + OFF_STF); e.a = p.in[5] + (l - 1) * 1024; e.b = p.in[6] + (l - 1) * 1024; }
                e.o = (bf16_t*)(ws + OFF_ZMIX); e.opart = (float2*)(ws + OFF_STM);
            } else {
                g.A = (const bf16_t*)(ws + OFF_H); g.Bt = (const bf16_t*)(ws + OFF_WT_F_OUT) + (size_t)l * 1024 * 2816; g.K = 2816;
                e.x = ws + OFF_ZMIX; e.stat = (const float2*)(ws + OFF_STM); e.a = p.in[3] + l * 1024; e.b = p.in[4] + l * 1024;
                e.o = (bf16_t*)(ws + OFF_ZFFN); e.opart = (float2*)(ws + OFF_STF);
            }
            run_gemm<1>(shm, g, e);
            GRID_SYNC();
        }
    }
    phase_final(p);
}

extern "C" void kernel_launch(void* const* d_in, const int* in_sizes, int n_in, void* d_out, int out_size, void* d_ws, size_t ws_size, hipStream_t stream) {
    static int grid = 0;
    if (grid == 0) {
        if (n_in != 19 || ws_size < WS_END) { fprintf(stderr, "kernel_launch: need 19 inputs and %zu bytes of workspace (got %d, %zu)\n", (size_t)WS_END, n_in, ws_size); grid = -1; return; }
        int dev = 0, cus = 0, per_cu = 0;
        hipGetDevice(&dev); hipDeviceGetAttribute(&cus, hipDeviceAttributeMultiprocessorCount, dev);
        if (hipFuncSetAttribute((const void*)hgrn2_chunkmlp_mega, hipFuncAttributeMaxDynamicSharedMemorySize, LDS_BYTES) != hipSuccess) { fprintf(stderr, "kernel_launch: hipFuncSetAttribute failed\n"); grid = -1; return; }
        if (hipOccupancyMaxActiveBlocksPerMultiprocessor(&per_cu, (const void*)hgrn2_chunkmlp_mega, 512, LDS_BYTES) != hipSuccess || per_cu < 1) { fprintf(stderr, "kernel_launch: occupancy query says %d blocks per CU\n", per_cu); grid = -1; return; }
        grid = cus;
        if (grid != 256) { fprintf(stderr, "kernel_launch: built for a 256-CU device (got %d CUs)\n", cus); grid = -1; return; }
    }
    if (grid < 0) return;
    Params p{};
    for (int i = 0; i < 19; ++i) p.in[i] = (const float*)d_in[i];
    p.out = (float*)d_out; p.ws = (unsigned char*)d_ws;
    void* args[] = {&p};
    if (hipMemsetAsync((char*)d_ws + OFF_BAR, 0, 16384, stream) != hipSuccess) { fprintf(stderr, "kernel_launch: hipMemsetAsync of the barrier words failed\n"); return; }
    hipError_t e = hipLaunchCooperativeKernel((void*)hgrn2_chunkmlp_mega, dim3(grid), dim3(512), args, LDS_BYTES, stream);
    if (e != hipSuccess) fprintf(stderr, "cooperative launch failed: %s (grid %d)\n", hipGetErrorString(e), grid);
}
```

```cpp
#include <hip/hip_runtime.h>
#include <hip/hip_cooperative_groups.h>
#include <cstdio>
namespace cg = cooperative_groups;

typedef unsigned short bf16_t;
typedef short bf16x8 __attribute__((ext_vector_type(8)));
typedef float f32x4 __attribute__((ext_vector_type(4)));
typedef float f32x2 __attribute__((ext_vector_type(2)));

constexpr int P = 16384, SR = 128, MT = P + SR, D = 1024, DFF = 2816;
constexpr float ALPHA = 1.681792830507429f;
constexpr float LN_EPS = 1e-5f, RMS_EPS = 1e-6f;
constexpr int LDS_BYTES = 131072 + 64 + 2048;

constexpr size_t al256(size_t x) { return (x + 255) & ~(size_t)255; }
constexpr size_t SZ_ACT = (size_t)MT * D * 2;
constexpr size_t OFF_WT_A_IN = 0;
constexpr size_t OFF_WT_A_OUT = OFF_WT_A_IN + (size_t)2 * 4096 * 1024 * 2;
constexpr size_t OFF_WT_B_IN = OFF_WT_A_OUT + (size_t)2 * 1024 * 1024 * 2;
constexpr size_t OFF_WT_B_OUT = OFF_WT_B_IN + (size_t)2 * 2048 * 1024 * 2;
constexpr size_t OFF_WT_F_IN = OFF_WT_B_OUT + (size_t)2 * 1024 * 1024 * 2;
constexpr size_t OFF_WT_F_OUT = OFF_WT_F_IN + (size_t)4 * 5632 * 1024 * 2;
constexpr size_t OFF_C1_A = OFF_WT_F_OUT + (size_t)4 * 1024 * 2816 * 2;
constexpr size_t OFF_C2_A = OFF_C1_A + 2 * 4096 * 4;
constexpr size_t OFF_C1_B = OFF_C2_A + 2 * 4096 * 4;
constexpr size_t OFF_C2_B = OFF_C1_B + 2 * 2048 * 4;
constexpr size_t OFF_C1_F = OFF_C2_B + 2 * 2048 * 4;
constexpr size_t OFF_C2_F = OFF_C1_F + 4 * 5632 * 4;
constexpr size_t OFF_LB = OFF_C2_F + 4 * 5632 * 4;
constexpr size_t OFF_ONES = OFF_LB + 2 * 1024 * 4;
constexpr size_t OFF_X0 = al256(OFF_ONES + 2 * 1024 * 4);
constexpr size_t OFF_ZMIX = OFF_X0 + SZ_ACT;
constexpr size_t OFF_ZFFN = OFF_ZMIX + SZ_ACT;
constexpr size_t SZ_ST = (size_t)MT * 16 * 8;
constexpr size_t OFF_STM = OFF_ZFFN + SZ_ACT;
constexpr size_t OFF_STF = OFF_STM + SZ_ST;
constexpr size_t OFF_STV = OFF_STF + SZ_ST;
constexpr size_t OFF_Q = OFF_STV + SZ_ST;
constexpr size_t OFF_K = OFF_Q + SZ_ACT;
constexpr size_t OFF_V = OFF_K + SZ_ACT;
constexpr size_t OFF_G = OFF_V + SZ_ACT;
constexpr size_t OFF_O = OFF_G + SZ_ACT;
constexpr size_t OFF_H = OFF_O + SZ_ACT;
constexpr size_t OFF_BAR = al256(OFF_H + (size_t)MT * DFF * 2);
constexpr size_t OFF_AM = OFF_BAR + 16384;
constexpr size_t WS_END = OFF_AM + (size_t)2048 * 4096 * 2;

constexpr size_t OUT_YP = 0, OUT_YS = (size_t)P * D, OUT_HSP = OUT_YS + (size_t)SR * D, OUT_HSS = OUT_HSP + (size_t)2 * 8 * 8 * 16384,
                 OUT_CVP = OUT_HSS + (size_t)2 * 128 * 8 * 16384, OUT_CVS = OUT_CVP + (size_t)2 * 8 * 128 * 1024;

struct Params { const float* in[19]; float* out; unsigned char* ws; };

__device__ __forceinline__ float bf2f(unsigned b) { return __uint_as_float(b << 16); }
__device__ __forceinline__ unsigned short f2bf(float f) { unsigned u = __float_as_uint(f); u += 0x7FFFu + ((u >> 16) & 1u); return (unsigned short)(u >> 16); }
__device__ __forceinline__ unsigned cvt_pk_bf16(float lo, float hi) { unsigned r; asm volatile("v_cvt_pk_bf16_f32 %0, %1, %2" : "=v"(r) : "v"(lo), "v"(hi)); return r; }
__device__ __forceinline__ f32x4 ld_bf4(const bf16_t* p) { const uint2 w = *(const uint2*)p; return (f32x4){bf2f(w.x & 0xffffu), bf2f(w.x >> 16), bf2f(w.y & 0xffffu), bf2f(w.y >> 16)}; }
__device__ __forceinline__ void st_bf4(bf16_t* p, f32x4 v) { uint2 w; w.x = cvt_pk_bf16(v[0], v[1]); w.y = cvt_pk_bf16(v[2], v[3]); *(uint2*)p = w; }
typedef unsigned v4u __attribute__((ext_vector_type(4)));
__device__ __forceinline__ __amdgpu_buffer_rsrc_t wt_rsrc(void* base) { return __builtin_amdgcn_make_buffer_rsrc(base, 0, 0x7ffffff0, 0x00020000); }
__device__ __forceinline__ void st16_wt(__amdgpu_buffer_rsrc_t r, unsigned byteoff, v4u w) { __builtin_amdgcn_raw_buffer_store_b128(w, r, byteoff, 0, 16); }
template <int CTRL> __device__ __forceinline__ float dppf(float x) { return __builtin_bit_cast(float, __builtin_amdgcn_mov_dpp(__builtin_bit_cast(int, x), CTRL, 0xf, 0xf, true)); }

namespace pg8 {
#define PG8_LAS __attribute__((address_space(3)))
constexpr int BM = 256, BK = 64, HALF = 128, HTB = HALF * BK * 2, STAGE_BYTES = 8 * HTB, NXCD = 8, WGM = 8;
__host__ __device__ __forceinline__ int lds_byte(int r, int c) { const int st = (r >> 4) * 2 + (c >> 5), rr = r & 15, cc = c & 31, ob = rr * 64 + cc * 2; return st * 1024 + (ob ^ (((ob >> 9) & 1) << 5)); }
__host__ __device__ __forceinline__ void stage_rc(int b, int& R, int& C) { const int st = b / 1024, sb = b % 1024, swz = sb ^ (((sb >> 9) & 1) << 5); R = (st >> 1) * 16 + swz / 64; C = (st & 1) * 32 + (swz % 64) / 2; }
struct Unit { int pm, pn; };
struct Gemm { const bf16_t* A; const bf16_t* Bt; int M, N, K; };
struct StaticOrder {
    int nM, nN, nwg, G, c;
    __host__ __device__ void init(int M, int N, int G_, int c_) { nM = M / BM; nN = N / BM; nwg = nM * nN; G = G_; c = c_; }
    __host__ __device__ bool next(int i, Unit& u) const {
        const int L = i * G + c; if (L >= nwg) return false;
        const int xcd = L & 7, off = L >> 3;
        u.pm = xcd * 8 + (off & 7); u.pn = off >> 3; return true;
    }
    __device__ __forceinline__ void a_ready(const Unit&) const {}
    __device__ __forceinline__ void done(const Unit&) const {}
};
template <class Epi, class Sched>
__device__ __forceinline__ void gemm_phase(PG8_LAS unsigned char* lds, const Gemm g, const Sched& S, const Epi& E) {
    int tid_ = threadIdx.x; asm volatile("" : "+v"(tid_));
    const int tid = tid_, wid = __builtin_amdgcn_readfirstlane(tid >> 6), lane = tid & 63, wr = wid >> 2, wc = wid & 3, fr = lane & 15, fq = lane >> 4;
    const int K = g.K, nt = K / BK;
    unsigned voffA[2];
#pragma unroll
    for (int i = 0; i < 2; ++i) { int R, C; stage_rc(tid * 16 + i * 8192, R, C); voffA[i] = (unsigned)(R * K + C) * 2u; }
    const size_t kstep = (size_t)(BK * 2);
    const size_t hstep = (size_t)HALF * K * 2;
    const size_t tstep = 2 * hstep;
    const unsigned ldsw = (unsigned)wid * 1024u;
    const int aoff = lds_byte(wr * 64 + fr, fq * 8), boff = lds_byte(wc * 32 + fr, fq * 8);
#define PG8_SA(b, h) (((b) * 2 + (h)) * HTB)
#define PG8_SB(b, h) ((4 + (b) * 2 + (h)) * HTB)
#define PG8_STAGE(bufoff, gbase, voff) do { _Pragma("unroll") for (int _i = 0; _i < 2; ++_i) \
        __builtin_amdgcn_global_load_lds((const unsigned*)((const char*)(gbase) + (voff)[_i]), (PG8_LAS unsigned*)(lds + (bufoff) + ldsw + _i * 8192), 16, 0, 0); } while (0)
#define PG8_LDA(dst, b, h) do { _Pragma("unroll") for (int m = 0; m < 4; ++m) _Pragma("unroll") for (int k = 0; k < 2; ++k) dst[m][k] = *(const PG8_LAS bf16x8*)(lds + PG8_SA(b, h) + aoff + m * 2048 + k * 1024); } while (0)
#define PG8_LDB(dst, b, h) do { _Pragma("unroll") for (int n = 0; n < 2; ++n) _Pragma("unroll") for (int k = 0; k < 2; ++k) dst[n][k] = *(const PG8_LAS bf16x8*)(lds + PG8_SB(b, h) + boff + n * 2048 + k * 1024); } while (0)
#define PG8_MMA(ai, bj, At, Bt) do { __builtin_amdgcn_s_setprio(1); _Pragma("unroll") for (int m = 0; m < 4; ++m) _Pragma("unroll") for (int n = 0; n < 2; ++n) _Pragma("unroll") for (int k = 0; k < 2; ++k) \
        acc[ai][bj][m][n] = __builtin_amdgcn_mfma_f32_16x16x32_bf16(Bt[n][k], At[m][k], acc[ai][bj][m][n], 0, 0, 0); __builtin_amdgcn_s_setprio(0); } while (0)
#define PG8_WAIT_V(n) asm volatile("s_waitcnt vmcnt(" #n ")" ::: "memory")
#define PG8_WAIT_L(n) asm volatile("s_waitcnt lgkmcnt(" #n ")" ::: "memory")
#define PG8_BAR __builtin_amdgcn_s_barrier()
#define PG8_SCHED __builtin_amdgcn_sched_barrier(0)
    Unit cur, nxt; int ui = 0;
    if (!S.next(0, cur)) return;
    f32x4 acc[2][2][4][2];
#pragma unroll
    for (int a = 0; a < 2; ++a)
#pragma unroll
        for (int b = 0; b < 2; ++b)
#pragma unroll
            for (int m = 0; m < 4; ++m)
#pragma unroll
                for (int n = 0; n < 2; ++n) acc[a][b][m][n] = (f32x4){0.f, 0.f, 0.f, 0.f};
    bf16x8 At[4][2], B0[2][2], B1[2][2];
    const char* cA = (const char*)g.A + (size_t)cur.pm * tstep; const char* cB = (const char*)g.Bt + (size_t)cur.pn * tstep;
    S.a_ready(cur);
    PG8_STAGE(PG8_SB(0, 0), cB, voffA); PG8_STAGE(PG8_SA(0, 0), cA, voffA); PG8_STAGE(PG8_SB(0, 1), cB + hstep, voffA); PG8_STAGE(PG8_SA(0, 1), cA + hstep, voffA);
    if (wr == 1) PG8_BAR;
    PG8_WAIT_V(4); PG8_BAR;
    PG8_STAGE(PG8_SB(1, 0), cB + kstep, voffA); PG8_STAGE(PG8_SA(1, 0), cA + kstep, voffA); PG8_STAGE(PG8_SB(1, 1), cB + hstep + kstep, voffA);
    PG8_WAIT_V(6); PG8_BAR;
    for (;;) {
        const bool has_next = S.next(ui + 1, nxt);
        const char* nA = has_next ? (const char*)g.A + (size_t)nxt.pm * tstep : cA; const char* nB = has_next ? (const char*)g.Bt + (size_t)nxt.pn * tstep : cB;
        for (int t = 0; t < nt; t += 2) {
            const bool last = (t == nt - 2);
            const char* a1 = cA + (size_t)(t + 1) * kstep;
            const char* a2 = last ? nA : cA + (size_t)(t + 2) * kstep; const char* b2 = last ? nB : cB + (size_t)(t + 2) * kstep;
            const char* a3 = a2 + kstep; const char* b3 = b2 + kstep;
            if (last && has_next) S.a_ready(nxt);
            PG8_LDB(B0, 0, 0); PG8_SCHED; PG8_LDA(At, 0, 0); PG8_STAGE(PG8_SA(1, 1), a1 + hstep, voffA);
            PG8_WAIT_L(8); PG8_BAR; PG8_WAIT_L(0); PG8_MMA(0, 0, At, B0); PG8_BAR; PG8_SCHED;
            PG8_LDB(B1, 0, 1); PG8_STAGE(PG8_SB(0, 0), b2, voffA);
            PG8_BAR; PG8_WAIT_L(0); PG8_MMA(0, 1, At, B1); PG8_BAR;
            PG8_LDA(At, 0, 1); PG8_STAGE(PG8_SA(0, 0), a2, voffA);
            PG8_BAR; PG8_WAIT_L(0); PG8_MMA(1, 0, At, B0); PG8_BAR; PG8_SCHED;
            PG8_STAGE(PG8_SB(0, 1), b2 + hstep, voffA);
            PG8_WAIT_V(6); PG8_BAR; PG8_MMA(1, 1, At, B1); PG8_BAR;
            PG8_LDB(B0, 1, 0); PG8_SCHED; PG8_LDA(At, 1, 0); PG8_STAGE(PG8_SA(0, 1), a2 + hstep, voffA);
            PG8_WAIT_L(8); PG8_BAR; PG8_WAIT_L(0); PG8_MMA(0, 0, At, B0); PG8_BAR; PG8_SCHED;
            PG8_LDB(B1, 1, 1); PG8_STAGE(PG8_SB(1, 0), b3, voffA);
            PG8_BAR; PG8_WAIT_L(0); PG8_MMA(0, 1, At, B1); PG8_BAR;
            PG8_LDA(At, 1, 1); PG8_STAGE(PG8_SA(1, 0), a3, voffA);
            PG8_BAR; PG8_WAIT_L(0); PG8_MMA(1, 0, At, B0); PG8_BAR; PG8_SCHED;
            PG8_STAGE(PG8_SB(1, 1), b3 + hstep, voffA);
            PG8_WAIT_V(6); PG8_BAR; PG8_MMA(1, 1, At, B1); PG8_BAR;
        }
        E(acc, cur, wr, wc, fr, fq); S.done(cur);
        if (!has_next) break;
#pragma unroll
        for (int a = 0; a < 2; ++a)
#pragma unroll
            for (int b = 0; b < 2; ++b)
#pragma unroll
                for (int m = 0; m < 4; ++m)
#pragma unroll
                    for (int n = 0; n < 2; ++n) acc[a][b][m][n] = (f32x4){0.f, 0.f, 0.f, 0.f};
        cur = nxt; cA = nA; cB = nB; ++ui;
    }
    PG8_WAIT_V(0);
    if (wr == 0) PG8_BAR;
    PG8_BAR;
#undef PG8_SA
#undef PG8_SB
#undef PG8_STAGE
#undef PG8_LDA
#undef PG8_LDB
#undef PG8_MMA
#undef PG8_WAIT_V
#undef PG8_WAIT_L
#undef PG8_BAR
#undef PG8_SCHED
}
}

struct Epi {
    const float2* stat;
    const float* a;
    const float* b;
    bf16_t* o;
    float2* opart;
    const void* x;
};
__device__ __forceinline__ f32x4 sigm4(f32x4 x) { f32x4 r; for (int i = 0; i < 4; ++i) r[i] = __builtin_amdgcn_rcpf(1.0f + __expf(-x[i])); return r; }
__device__ __forceinline__ f32x4 gelu4(f32x4 v) {
    f32x4 o;
#pragma unroll
    for (int i = 0; i < 4; ++i) {
        const float x = v[i], av = fabsf(x), t = __builtin_amdgcn_rcpf(av * 0.2316418882f + 1.0f);
        float q = t * 0.5307027145f + (-0.7265760135f); q = q * t + 0.7107068705f; q = q * t + (-0.142248368f); q = q * t + 0.127414796f; q = q * t;
        const float e = __builtin_amdgcn_exp2f(x * x * (-0.72134752044f));
        const float m = x * (q * e);
        o[i] = x < 0.f ? m : x - m;
    }
    return o;
}
template <int KIND> __device__ __forceinline__ f32x4 epi_val(int col, f32x4 a, float mu, float rstd, f32x4 va, f32x4 vb, f32x4 vx) {
    if constexpr (KIND == 0) {
        const f32x4 val = (a - va * mu) * rstd + vb;
        const int seg = col >> 10;
        if (seg == 0) return val * sigm4(val) * 0.08838834764831845f;
        else if (seg == 1) return (1.0f - vx) * sigm4(-val);
        else if (seg == 2) return val;
        else return val * sigm4(val);
    } else if constexpr (KIND == 1) {
        return ((vx - mu) * rstd * va + vb) * ALPHA + a;
    } else {
        return gelu4((a - va * mu) * rstd + vb);
    }
}
template <int KIND> __device__ __forceinline__ bf16_t* epi_ptr(const Epi& e, int row, int col) {
    if constexpr (KIND == 1) return e.o + (size_t)row * 1024 + col;
    else return e.o + (size_t)(col >> 10) * ((size_t)MT * 1024) + (size_t)row * 1024 + (col & 1023);
}
template <int KIND> __device__ __forceinline__ unsigned epi_off(int row, int col) {
    if constexpr (KIND == 1) return (unsigned)(row * 1024 + col) * 2u;
    else return ((unsigned)(col >> 10) * (unsigned)(MT * 1024) + (unsigned)(row * 1024 + (col & 1023))) * 2u;
}
template <int KIND> __device__ __forceinline__ f32x4 epi_quad(const Epi& e, int row, int col, f32x4 a, float mu, float rstd, f32x4 va, f32x4 vb, f32x4 vx) {
    const f32x4 y = epi_val<KIND>(col, a, mu, rstd, va, vb, vx); st_bf4(epi_ptr<KIND>(e, row, col), y); return y;
}
__device__ __forceinline__ f32x4 epi_val2(f32x4 ga, f32x4 ua, float mu, float rstd, f32x4 c1g, f32x4 c2g, f32x4 c1u, f32x4 c2u) {
    const f32x4 g = (ga - c1g * mu) * rstd + c2g;
    const f32x4 u = (ua - c1u * mu) * rstd + c2u;
    return g * sigm4(g) * u;
}
__device__ __forceinline__ void epi_quad2(const Epi& e, int row, int c, f32x4 ga, f32x4 ua, float mu, float rstd, f32x4 c1g, f32x4 c2g, f32x4 c1u, f32x4 c2u) {
    st_bf4(e.o + (size_t)row * DFF + c, epi_val2(ga, ua, mu, rstd, c1g, c2g, c1u, c2u));
}
__device__ __forceinline__ void st_bf8_wt(__amdgpu_buffer_rsrc_t r, unsigned byteoff, f32x4 y0, f32x4 y1) { v4u w; w.x = cvt_pk_bf16(y0[0], y0[1]); w.y = cvt_pk_bf16(y0[2], y0[3]); w.z = cvt_pk_bf16(y1[0], y1[1]); w.w = cvt_pk_bf16(y1[2], y1[3]); st16_wt(r, byteoff, w); }
__device__ __forceinline__ void stat_finish(float s, float q, float& mu, float& rstd) {
    mu = s * (1.0f / 1024.0f); const float var = fmaxf(q * (1.0f / 1024.0f) - mu * mu, 0.f); rstd = rsqrtf(var + LN_EPS);
}
__device__ __forceinline__ void rowstat_full(const float2* part, int row, float& mu, float& rstd) {
    const float4* pp = (const float4*)(part + (size_t)row * 16); float s = 0.f, q = 0.f;
#pragma unroll
    for (int i = 0; i < 8; ++i) { const float4 a = pp[i]; s += a.x + a.z; q += a.y + a.w; }
    stat_finish(s, q, mu, rstd);
}

constexpr int TAB_OFF = 131072 + 64;
template <int KIND> struct BigEpi {
    Epi e;
    __device__ __forceinline__ void operator()(const f32x4 (&acc)[2][2][4][2], const pg8::Unit& u, int wr, int wc, int fr, int fq) const {
        extern __shared__ __attribute__((aligned(16))) unsigned char shm_[];
        const float2* tab = (const float2*)(shm_ + TAB_OFF);
        const __amdgpu_buffer_rsrc_t orsrc = wt_rsrc(e.o);
        int pc0_ = u.pn * 256 + wc * 32 + fq * 8; asm volatile("" : "+v"(pc0_));
        const int pc0 = pc0_;
        f32x4 va[2][2], vb[2][2], vl[2][2];
#pragma unroll
        for (int bj = 0; bj < 2; ++bj)
#pragma unroll
            for (int n = 0; n < 2; ++n) {
                va[bj][n] = *(const f32x4*)(e.a + pc0 + bj * 128 + n * 4); vb[bj][n] = *(const f32x4*)(e.b + pc0 + bj * 128 + n * 4);
                if (KIND == 0 && (u.pn >> 2) == 1) vl[bj][n] = *(const f32x4*)((const float*)e.x + ((pc0 + bj * 128 + n * 4) & 1023)); else vl[bj][n] = (f32x4){0.f, 0.f, 0.f, 0.f};
            }
        constexpr int GR = (KIND == 3) ? 1 : 2;
#pragma unroll
        for (int g4 = 0; g4 < 8 / GR; ++g4) {
            const int ai = (g4 * GR) >> 2, m0 = (g4 * GR) & 3;
            int rowl_ = ai * 128 + wr * 64 + m0 * 16 + fr; asm volatile("" : "+v"(rowl_));
            const int rowl = rowl_, rowb = u.pm * 256 + rowl;
            uint4 zz[GR][2];
            if constexpr (KIND == 1) {
#pragma unroll
                for (int mm = 0; mm < GR; ++mm)
#pragma unroll
                    for (int bj = 0; bj < 2; ++bj) zz[mm][bj] = *(const uint4*)((const bf16_t*)e.x + (size_t)(rowb + mm * 16) * 1024 + pc0 + bj * 128);
                asm volatile("" ::: "memory");
            }
#pragma unroll
            for (int mm = 0; mm < GR; ++mm) {
                const int row = rowb + mm * 16, m = m0 + mm;
                float mu = 0.f, rstd = 1.f;
                if (e.stat) { const float2 ms = tab[rowl + mm * 16]; mu = ms.x; rstd = ms.y; }
                float s = 0.f, q = 0.f;
                if constexpr (KIND == 2) {
                    const f32x4 y0 = epi_val2(acc[ai][0][m][0], acc[ai][1][m][0], mu, rstd, va[0][0], vb[0][0], va[1][0], vb[1][0]);
                    const f32x4 y1 = epi_val2(acc[ai][0][m][1], acc[ai][1][m][1], mu, rstd, va[0][1], vb[0][1], va[1][1], vb[1][1]);
                    st_bf8_wt(orsrc, (unsigned)(row * DFF + u.pn * 128 + wc * 32 + fq * 8) * 2u, y0, y1);
                } else {
#pragma unroll
                    for (int bj = 0; bj < 2; ++bj) {
                        f32x4 x0 = vl[bj][0], x1 = vl[bj][1];
                        if constexpr (KIND == 1) { const uint4 w = zz[mm][bj]; x0 = (f32x4){bf2f(w.x & 0xffffu), bf2f(w.x >> 16), bf2f(w.y & 0xffffu), bf2f(w.y >> 16)}; x1 = (f32x4){bf2f(w.z & 0xffffu), bf2f(w.z >> 16), bf2f(w.w & 0xffffu), bf2f(w.w >> 16)}; }
                        const int col = pc0 + bj * 128;
                        v4u w;
                        { const f32x4 r0 = epi_val<KIND>(col, acc[ai][bj][m][0], mu, rstd, va[bj][0], vb[bj][0], x0);
                          w.x = cvt_pk_bf16(r0[0], r0[1]); w.y = cvt_pk_bf16(r0[2], r0[3]);
                          s += (r0[0] + r0[1]) + (r0[2] + r0[3]); q += (r0[0] * r0[0] + r0[1] * r0[1]) + (r0[2] * r0[2] + r0[3] * r0[3]); }
                        if constexpr (KIND == 3) __builtin_amdgcn_sched_barrier(0);
                        { const f32x4 r1 = epi_val<KIND>(col, acc[ai][bj][m][1], mu, rstd, va[bj][1], vb[bj][1], x1);
                          w.z = cvt_pk_bf16(r1[0], r1[1]); w.w = cvt_pk_bf16(r1[2], r1[3]);
                          s += (r1[0] + r1[1]) + (r1[2] + r1[3]); q += (r1[0] * r1[0] + r1[1] * r1[1]) + (r1[2] * r1[2] + r1[3] * r1[3]); }
                        st16_wt(orsrc, epi_off<KIND>(row, col), w);
                        if constexpr (KIND == 3) __builtin_amdgcn_sched_barrier(0);
                    }
                }
                if constexpr (KIND == 1 || KIND == 3) {
                    s += __shfl_xor(s, 16); s += __shfl_xor(s, 32); q += __shfl_xor(q, 16); q += __shfl_xor(q, 32);
                    if (fq == 0 && (KIND == 1 || u.pn >= 4)) e.opart[(size_t)row * 16 + (u.pn & 3) * 4 + wc] = make_float2(s, q);
                }
            }
            asm volatile("" ::: "memory");
        }
    }
};

template <int KIND> __device__ __forceinline__ void small_gemm(unsigned char* shm, const bf16_t* A, const bf16_t* Bt, int N, int K, const Epi& e) {
    float* red = (float*)shm;
    int tid_ = threadIdx.x; asm volatile("" : "+v"(tid_));
    const int tid = tid_, wid = tid >> 6, lane = tid & 63, fr = lane & 15, fq = lane >> 4;
    const int ncu = (KIND == 2) ? (N / 256) * 4 : N / 64, nunits = ncu * 4;
    const int nb = (KIND == 2) ? 128 : (int)gridDim.x, bi = (int)gridDim.x - 1 - (int)blockIdx.x;
    for (int unit = bi; unit < nunits && bi < nb; unit += nb) {
        const int ru = unit & 3, cu = unit >> 2, r0 = ru * 32;
        int b0, b1, lcol;
        if (KIND == 2) { const int cb = cu >> 2, cq = cu & 3; b0 = cb * 256 + cq * 32; b1 = b0 + 128; lcol = cb * 128 + cq * 32; }
        else { b0 = cu * 64; b1 = b0 + 32; lcol = b0; }
        const int kw = K >> 3, kbeg = wid * kw;
        f32x4 acc[2][2][2];
#pragma unroll
        for (int t = 0; t < 2; ++t)
#pragma unroll
            for (int i = 0; i < 2; ++i)
#pragma unroll
                for (int j = 0; j < 2; ++j) acc[t][i][j] = (f32x4){0.f, 0.f, 0.f, 0.f};
        const int rr = tid >> 4, jj = tid & 15, row = P + r0 + rr;
        float4 sp[8];
        if (e.stat) { const float4* pp = (const float4*)(e.stat + (size_t)row * 16);
#pragma unroll
            for (int i = 0; i < 8; ++i) sp[i] = pp[i]; }
        const int ecol = (KIND == 2) ? (((lcol + (jj & 7) * 4) >> 7) * 256 + ((lcol + (jj & 7) * 4) & 127)) : (lcol + (jj >> 3) * 32 + (jj & 7) * 4);
        const f32x4 pva = *(const f32x4*)(e.a + ecol), pvb = *(const f32x4*)(e.b + ecol);
        f32x4 pvx = (f32x4){0.f, 0.f, 0.f, 0.f}, pvy = pvx;
        if constexpr (KIND == 2) { pvx = *(const f32x4*)(e.a + ecol + 128); pvy = *(const f32x4*)(e.b + ecol + 128); }
        if constexpr (KIND == 0) { if ((ecol >> 10) == 1) pvx = *(const f32x4*)((const float*)e.x + (ecol & 1023)); }
        if constexpr (KIND == 1) pvx = ld_bf4((const bf16_t*)e.x + (size_t)row * 1024 + ecol);
        const bf16_t* ap = A + (size_t)(P + r0 + fr) * K + kbeg + 8 * fq;
        const bf16_t* bp0 = Bt + (size_t)(b0 + fr) * K + kbeg + 8 * fq;
        const bf16_t* bp1 = Bt + (size_t)(b1 + fr) * K + kbeg + 8 * fq;
        const size_t r16 = (size_t)16 * K;
#pragma unroll 4
        for (int kk = 0; kk < kw; kk += 32) {
            const bf16x8 a0 = *(const bf16x8*)(ap + kk), a1 = *(const bf16x8*)(ap + r16 + kk);
            const bf16x8 b00 = *(const bf16x8*)(bp0 + kk), b01 = *(const bf16x8*)(bp0 + r16 + kk), b10 = *(const bf16x8*)(bp1 + kk), b11 = *(const bf16x8*)(bp1 + r16 + kk);
            acc[0][0][0] = __builtin_amdgcn_mfma_f32_16x16x32_bf16(b00, a0, acc[0][0][0], 0, 0, 0);
            acc[0][0][1] = __builtin_amdgcn_mfma_f32_16x16x32_bf16(b01, a0, acc[0][0][1], 0, 0, 0);
            acc[0][1][0] = __builtin_amdgcn_mfma_f32_16x16x32_bf16(b00, a1, acc[0][1][0], 0, 0, 0);
            acc[0][1][1] = __builtin_amdgcn_mfma_f32_16x16x32_bf16(b01, a1, acc[0][1][1], 0, 0, 0);
            acc[1][0][0] = __builtin_amdgcn_mfma_f32_16x16x32_bf16(b10, a0, acc[1][0][0], 0, 0, 0);
            acc[1][0][1] = __builtin_amdgcn_mfma_f32_16x16x32_bf16(b11, a0, acc[1][0][1], 0, 0, 0);
            acc[1][1][0] = __builtin_amdgcn_mfma_f32_16x16x32_bf16(b10, a1, acc[1][1][0], 0, 0, 0);
            acc[1][1][1] = __builtin_amdgcn_mfma_f32_16x16x32_bf16(b11, a1, acc[1][1][1], 0, 0, 0);
        }
#pragma unroll
        for (int t = 0; t < 2; ++t)
#pragma unroll
            for (int i = 0; i < 2; ++i)
#pragma unroll
                for (int j = 0; j < 2; ++j) *(f32x4*)(red + ((wid * 2 + t) * 32 + 16 * i + fr) * 32 + 8 * fq + 4 * j) = acc[t][i][j];
        __syncthreads();
        float mu = 0.f, rstd = 1.f;
        if (e.stat) { float s = 0.f, q = 0.f;
#pragma unroll
            for (int i = 0; i < 8; ++i) { s += sp[i].x + sp[i].z; q += sp[i].y + sp[i].w; }
            stat_finish(s, q, mu, rstd); }
        if constexpr (KIND == 2) {
            if (jj < 8) {
                const int c4 = jj * 4; f32x4 ga = (f32x4){0.f, 0.f, 0.f, 0.f}, ua = ga;
#pragma unroll
                for (int w = 0; w < 8; ++w) { ga += *(const f32x4*)(red + ((w * 2 + 0) * 32 + rr) * 32 + c4); ua += *(const f32x4*)(red + ((w * 2 + 1) * 32 + rr) * 32 + c4); }
                epi_quad2(e, row, lcol + c4, ga, ua, mu, rstd, pva, pvb, pvx, pvy);
            }
        } else {
            const int t = jj >> 3, c4 = (jj & 7) * 4; f32x4 v = (f32x4){0.f, 0.f, 0.f, 0.f};
#pragma unroll
            for (int w = 0; w < 8; ++w) v += *(const f32x4*)(red + ((w * 2 + t) * 32 + rr) * 32 + c4);
            const f32x4 r = epi_quad<KIND>(e, row, ecol, v, mu, rstd, pva, pvb, pvx);
            if constexpr (KIND == 1 || KIND == 3) {
                float s = (r[0] + r[1]) + (r[2] + r[3]), q = (r[0] * r[0] + r[1] * r[1]) + (r[2] * r[2] + r[3] * r[3]);
                s += __shfl_xor(s, 1); s += __shfl_xor(s, 2); s += __shfl_xor(s, 4); s += __shfl_xor(s, 8);
                q += __shfl_xor(q, 1); q += __shfl_xor(q, 2); q += __shfl_xor(q, 4); q += __shfl_xor(q, 8);
                if (jj == 0 && (KIND == 1 || cu >= 16)) e.opart[(size_t)row * 16 + (cu & 15)] = make_float2(s, q);
            }
        }
        __syncthreads();
    }
}

template <int KIND> __device__ __forceinline__ void run_gemm(unsigned char* shm, const pg8::Gemm& g, const Epi& e) {
    pg8::StaticOrder S; S.init(g.M, g.N, (int)gridDim.x, (int)blockIdx.x);
    BigEpi<KIND> E{e};
    if (e.stat) {
        const int c = (int)blockIdx.x, pm = 8 * (c & 7) + ((c >> 3) & 7);
        if (threadIdx.x < 256) { float mu, rstd; rowstat_full(e.stat, pm * 256 + (int)threadIdx.x, mu, rstd); ((float2*)(shm + TAB_OFF))[threadIdx.x] = make_float2(mu, rstd); }
        __syncthreads();
    }
    pg8::gemm_phase((PG8_LAS unsigned char*)shm, g, S, E);
    __syncthreads();
    small_gemm<KIND>(shm, g.A, g.Bt, g.N, g.K, e);
}

struct MatDesc { const float* src; bf16_t* dst; int K, N; const float* gain; const float* bias; float* c1; float* c2; int swiglu; };
__device__ __forceinline__ int mat_tiles(int id) { return id < 2 ? 64 : id < 4 ? 16 : id < 6 ? 32 : id < 8 ? 16 : id < 12 ? 88 : 16; }
__device__ __forceinline__ void get_mat(const Params& p, int id, MatDesc& m) {
    unsigned char* ws = p.ws; m.gain = nullptr; m.bias = nullptr; m.c1 = nullptr; m.c2 = nullptr; m.swiglu = 0;
    if (id < 2) { const int j = id; m.src = p.in[8] + (size_t)j * 1024 * 4096; m.dst = (bf16_t*)(ws + OFF_WT_A_IN) + (size_t)j * 4096 * 1024; m.K = 1024; m.N = 4096;
        if (j > 0) { m.gain = p.in[5] + (2 * j - 1) * 1024; m.bias = p.in[6] + (2 * j - 1) * 1024; }
        m.c1 = (float*)(ws + OFF_C1_A) + j * 4096; m.c2 = (float*)(ws + OFF_C2_A) + j * 4096; }
    else if (id < 4) { const int j = id - 2; m.src = p.in[10] + (size_t)j * 1024 * 1024; m.dst = (bf16_t*)(ws + OFF_WT_A_OUT) + (size_t)j * 1024 * 1024; m.K = 1024; m.N = 1024; }
    else if (id < 6) { const int j = id - 4; m.src = p.in[11] + (size_t)j * 1024 * 2048; m.dst = (bf16_t*)(ws + OFF_WT_B_IN) + (size_t)j * 2048 * 1024; m.K = 1024; m.N = 2048;
        m.gain = p.in[5] + (2 * j) * 1024; m.bias = p.in[6] + (2 * j) * 1024;
        m.c1 = (float*)(ws + OFF_C1_B) + j * 2048; m.c2 = (float*)(ws + OFF_C2_B) + j * 2048; }
    else if (id < 8) { const int j = id - 6; m.src = p.in[16] + (size_t)j * 1024 * 1024; m.dst = (bf16_t*)(ws + OFF_WT_B_OUT) + (size_t)j * 1024 * 1024; m.K = 1024; m.N = 1024; }
    else if (id < 12) { const int l = id - 8; m.src = p.in[17] + (size_t)l * 1024 * 5632; m.dst = (bf16_t*)(ws + OFF_WT_F_IN) + (size_t)l * 5632 * 1024; m.K = 1024; m.N = 5632;
        m.gain = p.in[3] + l * 1024; m.bias = p.in[4] + l * 1024;
        m.c1 = (float*)(ws + OFF_C1_F) + l * 5632; m.c2 = (float*)(ws + OFF_C2_F) + l * 5632; m.swiglu = 1; }
    else { const int l = id - 12; m.src = p.in[18] + (size_t)l * 2816 * 1024; m.dst = (bf16_t*)(ws + OFF_WT_F_OUT) + (size_t)l * 1024 * 2816; m.K = 2816; m.N = 1024; }
}
__device__ __forceinline__ void phase_prep(const Params& p, unsigned char* shm) {
    int tid_ = threadIdx.x; asm volatile("" : "+v"(tid_)); const int tid = tid_;
    unsigned short* tile = (unsigned short*)shm;
    float* red = (float*)(shm + 64 * 264 * 2);
    for (int task = blockIdx.x; task < 672; task += gridDim.x) {
        int id = 0, t = task; while (t >= mat_tiles(id)) { t -= mat_tiles(id); ++id; }
        MatDesc m; get_mat(p, id, m);
        const int n0 = t * 64;
        int nd0 = n0;
        if (m.swiglu) { const int c = n0 < 2816 ? n0 : n0 - 2816; nd0 = (c >> 7) * 256 + (c & 127) + (n0 < 2816 ? 0 : 128); }
        const int kk = tid >> 4, n4 = (tid & 15) * 4;
        float c1a[4] = {0.f, 0.f, 0.f, 0.f}, c2a[4] = {0.f, 0.f, 0.f, 0.f};
        float4 wq[8]; float gq[8], bq[8];
#pragma unroll
        for (int p8 = 0; p8 < 8; ++p8) { const int k = p8 * 32 + kk; wq[p8] = *(const float4*)(m.src + (size_t)k * m.N + n0 + n4); gq[p8] = m.gain ? m.gain[k] : 1.0f; bq[p8] = m.bias ? m.bias[k] : 0.0f; }
        for (int k0 = 0; k0 < m.K; k0 += 256) {
#pragma unroll
            for (int p8 = 0; p8 < 8; ++p8) {
                const float wv[4] = {wq[p8].x, wq[p8].y, wq[p8].z, wq[p8].w};
#pragma unroll
                for (int i = 0; i < 4; ++i) { const unsigned short r = f2bf(wv[i] * gq[p8]); tile[(n4 + i) * 264 + p8 * 32 + kk] = r; c1a[i] += bf2f(r); c2a[i] += bq[p8] * wv[i]; }
            }
            if (k0 + 256 < m.K) {
#pragma unroll
                for (int p8 = 0; p8 < 8; ++p8) { const int k = k0 + 256 + p8 * 32 + kk; wq[p8] = *(const float4*)(m.src + (size_t)k * m.N + n0 + n4); gq[p8] = m.gain ? m.gain[k] : 1.0f; bq[p8] = m.bias ? m.bias[k] : 0.0f; }
            }
            asm volatile("s_waitcnt lgkmcnt(0)" ::: "memory"); __builtin_amdgcn_s_barrier(); asm volatile("" ::: "memory");
            const int n = tid >> 3, cl = n & 31, nrow = (n & 32) + 16 * ((cl >> 2) & 1) + 4 * (cl >> 3) + (cl & 3);
#pragma unroll
            for (int p2 = 0; p2 < 4; ++p2) { const int k8 = (tid & 7) * 8 + p2 * 64; const uint4 v = *(const uint4*)&tile[n * 264 + k8]; *(uint4*)(m.dst + (size_t)(nd0 + nrow) * m.K + k0 + k8) = v; }
            asm volatile("s_waitcnt lgkmcnt(0)" ::: "memory"); __builtin_amdgcn_s_barrier(); asm volatile("" ::: "memory");
        }
        if (m.c1) {
#pragma unroll
            for (int i = 0; i < 4; ++i) { red[(0 * 32 + kk) * 64 + n4 + i] = c1a[i]; red[(1 * 32 + kk) * 64 + n4 + i] = c2a[i]; }
            __syncthreads();
            if (tid < 128) { const int which = tid >> 6, n = tid & 63; float s = 0.f; for (int k2 = 0; k2 < 32; ++k2) s += red[(which * 32 + k2) * 64 + n]; (which ? m.c2 : m.c1)[nd0 + n] = s; }
            __syncthreads();
        }
    }
    bf16_t* X0 = (bf16_t*)(p.ws + OFF_X0);
    for (size_t i = (size_t)blockIdx.x * 512 + tid; i < (size_t)MT * 256; i += (size_t)gridDim.x * 512) {
        const size_t e0 = i * 4; const float* src = e0 < (size_t)P * D ? p.in[0] + e0 : p.in[1] + (e0 - (size_t)P * D);
        st_bf4(X0 + e0, *(const f32x4*)src);
    }
    if (blockIdx.x == 0) {
        float* LB = (float*)(p.ws + OFF_LB);
        for (int c = tid; c < 1024; c += 512) {
            const float r0 = p.in[7][c], r1 = p.in[7][1024 + c], r2 = p.in[7][2048 + c], r3 = p.in[7][3072 + c];
            const float mx = fmaxf(fmaxf(r0, r1), fmaxf(r2, r3));
            const float e0 = expf(r0 - mx), e1 = expf(r1 - mx), e2 = expf(r2 - mx), e3 = expf(r3 - mx);
            LB[c] = 0.f; LB[1024 + c] = (e1 + e2) / (e0 + e1 + e2 + e3);
            float* ONES = (float*)(p.ws + OFF_ONES); ONES[c] = 1.0f; ONES[1024 + c] = 0.0f;
        }
    }
}

__device__ __forceinline__ void unpack8(const uint4 r, float* d) {
    *(float4*)d = make_float4(bf2f(r.x & 0xffffu), bf2f(r.x >> 16), bf2f(r.y & 0xffffu), bf2f(r.y >> 16));
    *(float4*)(d + 4) = make_float4(bf2f(r.z & 0xffffu), bf2f(r.z >> 16), bf2f(r.w & 0xffffu), bf2f(r.w >> 16));
}
__device__ __forceinline__ void phase_hgrn_pre(const Params& p, unsigned char* shm) {
    bf16_t* RAWq = (bf16_t*)shm;
    bf16_t* RAWk = RAWq + 64 * 128;
    bf16_t* Qm = RAWk + 64 * 128;
    bf16_t* Km = Qm + 64 * 136;
    bf16_t* KmT = Km + 64 * 136;
    bf16_t* AmL = KmT + 128 * 72;
    float* tot = (float*)(AmL + 64 * 72);
    bf16_t* Q = (bf16_t*)(p.ws + OFF_Q); const bf16_t* Kb = (const bf16_t*)(p.ws + OFF_K); bf16_t* KT = (bf16_t*)(p.ws + OFF_ZMIX); float* EV = (float*)(p.ws + OFF_STM);
    bf16_t* AM = (bf16_t*)(p.ws + OFF_AM);
    int tid_ = threadIdx.x; asm volatile("" : "+v"(tid_));
    const int tid = tid_, tq = tid >> 7, kcol = tid & 127, lt = tid >> 3, lseg = (tid & 7) * 16, wid = tid >> 6, lane = tid & 63, fr = lane & 15, fq = lane >> 4;
#define PRE_BAR() do { asm volatile("s_waitcnt lgkmcnt(0)" ::: "memory"); __builtin_amdgcn_s_barrier(); asm volatile("" ::: "memory"); } while (0)
    uint4 nq0, nq1, nk0, nk1;
    { const int it0 = (int)blockIdx.x, c0 = it0 & 31, h0 = (it0 >> 5) & 7, b0 = it0 >> 8; const size_t g0 = (size_t)(b0 * 2048 + c0 * 64 + lt) * 1024 + h0 * 128 + lseg;
      nq0 = *(const uint4*)(Q + g0); nq1 = *(const uint4*)(Q + g0 + 8); nk0 = *(const uint4*)(Kb + g0); nk1 = *(const uint4*)(Kb + g0 + 8); }
    for (int item = blockIdx.x; item < 2048; item += gridDim.x) {
        const int c = item & 31, h = (item >> 5) & 7, b = item >> 8;
        const size_t goff = (size_t)(b * 2048 + c * 64 + lt) * 1024 + h * 128 + lseg;
        *(uint4*)(RAWq + lt * 128 + lseg) = nq0; *(uint4*)(RAWq + lt * 128 + lseg + 8) = nq1;
        *(uint4*)(RAWk + lt * 128 + lseg) = nk0; *(uint4*)(RAWk + lt * 128 + lseg + 8) = nk1;
        { const int itn = item + (int)gridDim.x;
          if (itn < 2048) { const int cn = itn & 31, hn = (itn >> 5) & 7, bn = itn >> 8; const size_t gn = (size_t)(bn * 2048 + cn * 64 + lt) * 1024 + hn * 128 + lseg;
            nq0 = *(const uint4*)(Q + gn); nq1 = *(const uint4*)(Q + gn + 8); nk0 = *(const uint4*)(Kb + gn); nk1 = *(const uint4*)(Kb + gn + 8); } }
        PRE_BAR();
        float lf[16], kv[16]; float cs = 0.f;
#pragma unroll
        for (int i = 0; i < 16; ++i) { kv[i] = bf2f(RAWk[(16 * tq + i) * 128 + kcol]); lf[i] = __builtin_amdgcn_logf(fmaxf(1.0f - kv[i], 1e-6f)); cs += lf[i]; }
        tot[tq * 128 + kcol] = cs;
        PRE_BAR();
        {
            const float t0 = tot[kcol], t1 = tot[128 + kcol], t2 = tot[256 + kcol], t3 = tot[384 + kcol];
            float g = (tq > 0 ? t0 : 0.f) + (tq > 1 ? t1 : 0.f) + (tq > 2 ? t2 : 0.f);
            const float gmid = t0 + t1;
            if (tq == 0) { float* ev = EV + (size_t)(b * 32 + c) * 1024 + h * 128 + kcol; ev[0] = __builtin_amdgcn_exp2f(gmid); ev[262144] = __builtin_amdgcn_exp2f(t2 + t3); }
            unsigned kmt[8];
#pragma unroll
            for (int i = 0; i < 16; i += 2) {
                const int t = 16 * tq + i;
                const float ga = g + lf[i], gb = ga + lf[i + 1]; g = gb;
                const float qa = bf2f(RAWq[t * 128 + kcol]), qb = bf2f(RAWq[(t + 1) * 128 + kcol]);
                const unsigned pq = cvt_pk_bf16(qa * __builtin_amdgcn_exp2f(fminf(ga - gmid, 126.f)), qb * __builtin_amdgcn_exp2f(fminf(gb - gmid, 126.f)));
                const unsigned pk = cvt_pk_bf16(kv[i] * __builtin_amdgcn_exp2f(fminf(gmid - ga, 126.f)), kv[i + 1] * __builtin_amdgcn_exp2f(fminf(gmid - gb, 126.f)));
                Qm[t * 136 + kcol] = (bf16_t)(pq & 0xffffu); Qm[(t + 1) * 136 + kcol] = (bf16_t)(pq >> 16);
                Km[t * 136 + kcol] = (bf16_t)(pk & 0xffffu); Km[(t + 1) * 136 + kcol] = (bf16_t)(pk >> 16);
                kmt[i >> 1] = pk;
            }
            *(uint4*)(KmT + kcol * 72 + 16 * tq) = make_uint4(kmt[0], kmt[1], kmt[2], kmt[3]);
            *(uint4*)(KmT + kcol * 72 + 16 * tq + 8) = make_uint4(kmt[4], kmt[5], kmt[6], kmt[7]);
        }
        PRE_BAR();
#pragma unroll
        for (int hf = 0; hf < 2; ++hf) {
            const int idx = wid + 8 * hf, tt = idx >> 2, st = idx & 3;
            f32x4 a = (f32x4){0.f, 0.f, 0.f, 0.f};
            if (st <= tt) {
#pragma unroll
                for (int k4 = 0; k4 < 4; ++k4) {
                    const bf16x8 X = *(const bf16x8*)(Km + (16 * st + fr) * 136 + 32 * k4 + 8 * fq), Y = *(const bf16x8*)(Qm + (16 * tt + fr) * 136 + 32 * k4 + 8 * fq);
                    a = __builtin_amdgcn_mfma_f32_16x16x32_bf16(X, Y, a, 0, 0, 0);
                }
            }
            const int t = 16 * tt + fr;
#pragma unroll
            for (int r = 0; r < 4; ++r) if (16 * st + 4 * fq + r > t) a[r] = 0.f;
            st_bf4(AmL + t * 72 + 16 * st + 4 * fq, a);
        }
        PRE_BAR();
        *(uint4*)(Q + goff) = *(const uint4*)(Qm + lt * 136 + lseg); *(uint4*)(Q + goff + 8) = *(const uint4*)(Qm + lt * 136 + lseg + 8);
        { const int kk = tid >> 2, sg = (tid & 3) * 16; bf16_t* dst = KT + (size_t)item * 8192 + kk * 64 + sg;
          *(uint4*)dst = *(const uint4*)(KmT + kk * 72 + sg); *(uint4*)(dst + 8) = *(const uint4*)(KmT + kk * 72 + sg + 8); }
        *(uint4*)(AM + (size_t)item * 4096 + lt * 64 + (tid & 7) * 8) = *(const uint4*)(AmL + lt * 72 + (tid & 7) * 8);
        PRE_BAR();
    }
#undef PRE_BAR
}
__device__ __forceinline__ void phase_hgrn_prompt(const Params& p, unsigned char* shm, int j) {
    constexpr int SET = 64 * 136 + 128 * 72 + 64 * 72 + 32 * 72 + 32 * 136;
    const bf16_t* Q = (const bf16_t*)(p.ws + OFF_Q); const bf16_t* Vb = (const bf16_t*)(p.ws + OFF_V);
    const bf16_t* KT = (const bf16_t*)(p.ws + OFF_ZMIX); const float* EV = (const float*)(p.ws + OFF_STM); const bf16_t* AM = (const bf16_t*)(p.ws + OFF_AM);
    float* ORAW = (float*)(p.ws + OFF_H);
    int tid_ = threadIdx.x; asm volatile("" : "+v"(tid_));
    const int tid = tid_, wid = tid >> 6, lane = tid & 63, fr = lane & 15, fq = lane >> 4;
    const int lt = tid >> 3, lseg = (tid & 7) * 16, kk = tid >> 2, sg = (tid & 3) * 16, ks4 = 16 * wid + 4 * fq;
    for (int task = blockIdx.x; task < 256; task += gridDim.x) {
        const int bh = (task & 7) * 8 + (task >> 5), vq = (task >> 3) & 3, b = bh >> 3, h = bh & 7, rowbase = b * 2048;
        f32x4 S[2]; S[0] = (f32x4){0.f, 0.f, 0.f, 0.f}; S[1] = S[0];
        uint4 RA_q0, RA_q1, RA_t0, RA_t1, RA_a, RA_v = make_uint4(0, 0, 0, 0), RB_q0, RB_q1, RB_t0, RB_t1, RB_a, RB_v = make_uint4(0, 0, 0, 0);
        f32x4 RA_em, RA_ee, RB_em, RB_ee;
#define HG_LOAD(cc, R) do { \
            const size_t off = (size_t)(rowbase + (cc) * 64 + lt) * 1024 + h * 128 + lseg; \
            R##_q0 = *(const uint4*)(Q + off); R##_q1 = *(const uint4*)(Q + off + 8); \
            const bf16_t* kt = KT + (size_t)(bh * 32 + (cc)) * 8192 + kk * 64 + sg; R##_t0 = *(const uint4*)kt; R##_t1 = *(const uint4*)(kt + 8); \
            R##_a = *(const uint4*)(AM + (size_t)(bh * 32 + (cc)) * 4096 + lt * 64 + (tid & 7) * 8); \
            if (tid < 256) R##_v = *(const uint4*)(Vb + (size_t)(rowbase + (cc) * 64 + (tid >> 2)) * 1024 + h * 128 + vq * 32 + (tid & 3) * 8); \
            const float* ev = EV + (size_t)(b * 32 + (cc)) * 1024 + h * 128 + ks4; R##_em = *(const f32x4*)ev; R##_ee = *(const f32x4*)(ev + 262144); \
} while (0)
#define HG_BODY(c, R) do { \
            bf16_t* Qm = (bf16_t*)shm + ((c) & 1) * SET; bf16_t* KmT = Qm + 64 * 136; bf16_t* Am = KmT + 128 * 72; bf16_t* VT = Am + 64 * 72; bf16_t* SpT = VT + 32 * 72; \
            *(uint4*)(Qm + lt * 136 + lseg) = R##_q0; *(uint4*)(Qm + lt * 136 + lseg + 8) = R##_q1; \
            *(uint4*)(KmT + kk * 72 + sg) = R##_t0; *(uint4*)(KmT + kk * 72 + sg + 8) = R##_t1; \
            *(uint4*)(Am + lt * 72 + (tid & 7) * 8) = R##_a; \
            if (tid < 256) { const int t = tid >> 2, c8 = (tid & 3) * 8; const unsigned w[4] = {R##_v.x, R##_v.y, R##_v.z, R##_v.w}; \
_Pragma("unroll") \
                for (int i = 0; i < 4; ++i) { VT[(c8 + 2 * i) * 72 + t] = (bf16_t)(w[i] & 0xffffu); VT[(c8 + 2 * i + 1) * 72 + t] = (bf16_t)(w[i] >> 16); } } \
            const f32x4 e_mid = R##_em, e_em = R##_ee, e_end = R##_em * R##_ee; \
_Pragma("unroll") \
            for (int it = 0; it < 2; ++it) { \
                st_bf4(SpT + (16 * it + fr) * 136 + ks4, e_mid * S[it]); } \
            asm volatile("s_waitcnt lgkmcnt(0)" ::: "memory"); __builtin_amdgcn_s_barrier(); asm volatile("" ::: "memory"); \
            if ((c) + 2 < 32) HG_LOAD(((c)) + 2, R); \
              \
            const int it = wid >> 2, tt = wid & 3; \
            bf16x8 YQ[4], XO[4], XS0[2], XS1[2], YS[2], YA[2]; \
_Pragma("unroll") \
            for (int k4 = 0; k4 < 4; ++k4) { \
                YQ[k4] = *(const bf16x8*)(Qm + (16 * tt + fr) * 136 + 32 * k4 + 8 * fq); XO[k4] = *(const bf16x8*)(SpT + (16 * it + fr) * 136 + 32 * k4 + 8 * fq); } \
_Pragma("unroll") \
            for (int k2 = 0; k2 < 2; ++k2) { XS0[k2] = *(const bf16x8*)(VT + (fr) * 72 + 32 * k2 + 8 * fq); XS1[k2] = *(const bf16x8*)(VT + (16 + fr) * 72 + 32 * k2 + 8 * fq); \
                YS[k2] = *(const bf16x8*)(KmT + (16 * wid + fr) * 72 + 32 * k2 + 8 * fq); YA[k2] = *(const bf16x8*)(Am + (16 * tt + fr) * 72 + 32 * k2 + 8 * fq); } \
            f32x4 o = (f32x4){0.f, 0.f, 0.f, 0.f}, d0 = o, d1 = o; \
_Pragma("unroll") \
            for (int k4 = 0; k4 < 4; ++k4) { \
                o = __builtin_amdgcn_mfma_f32_16x16x32_bf16(XO[k4], YQ[k4], o, 0, 0, 0); \
                if (k4 < 2) { d0 = __builtin_amdgcn_mfma_f32_16x16x32_bf16(YS[k4], XS0[k4], d0, 0, 0, 0); d1 = __builtin_amdgcn_mfma_f32_16x16x32_bf16(YS[k4], XS1[k4], d1, 0, 0, 0); \
                              o = __builtin_amdgcn_mfma_f32_16x16x32_bf16(it ? XS1[k4] : XS0[k4], YA[k4], o, 0, 0, 0); } } \
            S[0] = S[0] * e_end + d0 * e_em; S[1] = S[1] * e_end + d1 * e_em; \
            *(f32x4*)(ORAW + (size_t)(rowbase + (c) * 64 + 16 * tt + fr) * 1024 + h * 128 + vq * 32 + 16 * it + 4 * fq) = o; \
} while (0)
        HG_LOAD(0, RA); HG_LOAD(1, RB);
#pragma nounroll
        for (int c = 0; c < 32; c += 2) { const int c1 = c + 1; HG_BODY(c, RA); HG_BODY(c1, RB); }
#undef HG_LOAD
#undef HG_BODY
        float* so = p.out + OUT_HSP + ((size_t)((j * 8 + b) * 8 + h) * 128) * 128;
#pragma unroll
        for (int i2 = 0; i2 < 2; ++i2)
#pragma unroll
            for (int r = 0; r < 4; ++r) so[(size_t)(ks4 + r) * 128 + vq * 32 + 16 * i2 + fr] = S[i2][r];
        __syncthreads();
    }
}
__device__ __forceinline__ void phase_hgrn_sample(const Params& p, unsigned char* shm, int j) {
    float* qs = (float*)shm; float* ks = qs + 128; float* red = ks + 128; float* ssq = red + 16 * 128;
    const bf16_t* Q = (const bf16_t*)(p.ws + OFF_Q); const bf16_t* Kb = (const bf16_t*)(p.ws + OFF_K); const bf16_t* Vb = (const bf16_t*)(p.ws + OFF_V); const bf16_t* G = (const bf16_t*)(p.ws + OFF_G);
    bf16_t* O = (bf16_t*)(p.ws + OFF_O);
    int tid_ = threadIdx.x; asm volatile("" : "+v"(tid_));
    const int tid = tid_, c4 = (tid & 31) * 4, kr = tid >> 5;
    for (int task = blockIdx.x; task < 1024; task += gridDim.x) {
        const int b = task >> 3, h = task & 7; const size_t rowoff = (size_t)(P + b) * 1024 + h * 128;
        if (tid < 128) { qs[tid] = bf2f(Q[rowoff + tid]); ks[tid] = bf2f(Kb[rowoff + tid]); }
        const f32x4 v4 = ld_bf4(Vb + rowoff + c4);
        __syncthreads();
        const float* Sin = p.in[2] + ((size_t)(j * 128 + b) * 8 + h) * 16384; float* Sout = p.out + OUT_HSS + ((size_t)(j * 128 + b) * 8 + h) * 16384;
        f32x4 o4 = (f32x4){0.f, 0.f, 0.f, 0.f};
#pragma unroll
        for (int i = 0; i < 8; ++i) { const int k = kr + 16 * i; f32x4 s = *(const f32x4*)(Sin + k * 128 + c4); s = s + (v4 - s) * ks[k]; *(f32x4*)(Sout + k * 128 + c4) = s; o4 += s * qs[k]; }
        *(f32x4*)(red + kr * 128 + c4) = o4;
        __syncthreads();
        float o = 0.f;
        if (tid < 128) {
#pragma unroll
            for (int r = 0; r < 16; ++r) o += red[r * 128 + tid];
            float ss = o * o;
#pragma unroll
            for (int off = 1; off < 64; off <<= 1) ss += __shfl_xor(ss, off);
            if ((tid & 63) == 0) ssq[tid >> 6] = ss;
        }
        __syncthreads();
        if (tid < 128) {
            const float r = rsqrtf((ssq[0] + ssq[1]) * (1.0f / 128.0f) + RMS_EPS);
            O[rowoff + tid] = f2bf(o * r * p.in[9][j * 128 + tid] * bf2f(G[rowoff + tid]));
        }
        __syncthreads();
    }
}
__device__ __forceinline__ void phase_rms(const Params& p, int j) {
    const float* ORAW = (const float*)(p.ws + OFF_H); const bf16_t* G = (const bf16_t*)(p.ws + OFF_G); bf16_t* O = (bf16_t*)(p.ws + OFF_O);
    int tid_ = threadIdx.x; asm volatile("" : "+v"(tid_)); const int tid = tid_;
    const f32x4 ng = *(const f32x4*)(p.in[9] + j * 128 + (tid & 31) * 4);
    for (int it = blockIdx.x; it < P * 8 / 16; it += gridDim.x) {
        const int pair = it * 16 + (tid >> 5), row = pair >> 3, h = pair & 7; const size_t off = (size_t)row * 1024 + h * 128 + (tid & 31) * 4;
        const f32x4 o4 = *(const f32x4*)(ORAW + off);
        float ss = (o4[0] * o4[0] + o4[1] * o4[1]) + (o4[2] * o4[2] + o4[3] * o4[3]);
#pragma unroll
        for (int o = 1; o < 32; o <<= 1) ss += __shfl_xor(ss, o);
        const float r = rsqrtf(ss * (1.0f / 128.0f) + RMS_EPS);
        st_bf4(O + off, o4 * r * ng * ld_bf4(G + off));
    }
}

#define SP_BAR() do { asm volatile("s_waitcnt lgkmcnt(0)" ::: "memory"); __builtin_amdgcn_s_barrier(); asm volatile("" ::: "memory"); } while (0)
__device__ __forceinline__ void phase_spatial(const Params& p, unsigned char* shm, int jb) {
    bf16_t* vnT = (bf16_t*)shm;
    float2* st = (float2*)(shm + 128 * 136 * 2);
    const bf16_t* U = (const bf16_t*)(p.ws + OFF_Q); const bf16_t* Vb = (const bf16_t*)(p.ws + OFF_K); bf16_t* O = (bf16_t*)(p.ws + OFF_O);
    const float2* STV = (const float2*)(p.ws + OFF_STV);
    const float* lng = p.in[12] + jb * 1024; const float* lnb = p.in[13] + jb * 1024; const float* wsp = p.in[14] + (size_t)jb * 8 * 128 * 128; const float* bsp = p.in[15] + jb * 8 * 128;
    float* cvp = p.out + OUT_CVP + (size_t)jb * 8 * 128 * 1024;
    int tid_ = threadIdx.x; asm volatile("" : "+v"(tid_));
    const int tid = tid_, wid = tid >> 6, lane = tid & 63, fr = lane & 15, fq = lane >> 4;
    for (int task = blockIdx.x; task < 256; task += gridDim.x) {
        const int gh = task & 1, cn = task >> 1, b = cn >> 4, n = cn & 15, r0 = b * 2048 + n * 128;
        if (tid < 128) { float mu, rstd; rowstat_full(STV, r0 + tid, mu, rstd); st[tid] = make_float2(mu, rstd); }
        __syncthreads();
        const int ic = (tid & 63) * 2, is8 = (tid >> 6) * 8;
        const int t = 16 * wid + fr;
        unsigned vcur[2][8], vnxt[2][8];
#pragma unroll
        for (int h2 = 0; h2 < 2; ++h2)
#pragma unroll
            for (int s = 0; s < 8; ++s) { vcur[h2][s] = *(const unsigned*)(Vb + (size_t)(r0 + is8 + 64 * h2 + s) * 1024 + gh * 512 + ic); vnxt[h2][s] = 0u; }
        for (int gi = 0; gi < 4; ++gi) {
            const int g = gh * 4 + gi, c0 = g * 128;
            float4 wa[4], wb[4]; uint2 ureg[8];
#pragma unroll
            for (int ks = 0; ks < 4; ++ks) { const float* wp = wsp + ((size_t)g * 128 + t) * 128 + 32 * ks + 8 * fq; wa[ks] = *(const float4*)wp; wb[ks] = *(const float4*)(wp + 4); }
#pragma unroll
            for (int ct = 0; ct < 8; ++ct) ureg[ct] = *(const uint2*)(U + (size_t)(r0 + t) * 1024 + c0 + 16 * ct + 4 * fq);
            const float bias = bsp[g * 128 + t];
            if (gi < 3) {
#pragma unroll
                for (int h2 = 0; h2 < 2; ++h2)
#pragma unroll
                    for (int s = 0; s < 8; ++s) vnxt[h2][s] = *(const unsigned*)(Vb + (size_t)(r0 + is8 + 64 * h2 + s) * 1024 + c0 + 128 + ic);
            }
            { const float g0 = lng[c0 + ic], g1 = lng[c0 + ic + 1], b0 = lnb[c0 + ic], b1 = lnb[c0 + ic + 1];
#pragma unroll
              for (int h2 = 0; h2 < 2; ++h2) {
                unsigned w0[4], w1[4];
#pragma unroll
                for (int s2 = 0; s2 < 4; ++s2) {
                    float a0[2], a1[2];
#pragma unroll
                    for (int e = 0; e < 2; ++e) {
                        const int s = is8 + 64 * h2 + s2 * 2 + e; const unsigned vv = vcur[h2][s2 * 2 + e]; const float2 ms = st[s];
                        a0[e] = (bf2f(vv & 0xffffu) - ms.x) * ms.y * g0 + b0; a1[e] = (bf2f(vv >> 16) - ms.x) * ms.y * g1 + b1;
                        if (n == 15) *(float2*)(cvp + ((size_t)(b * 128 + s)) * 1024 + c0 + ic) = make_float2(a0[e], a1[e]);
                    }
                    w0[s2] = cvt_pk_bf16(a0[0], a0[1]); w1[s2] = cvt_pk_bf16(a1[0], a1[1]);
                }
                *(uint4*)(vnT + ic * 136 + is8 + 64 * h2) = make_uint4(w0[0], w0[1], w0[2], w0[3]);
                *(uint4*)(vnT + (ic + 1) * 136 + is8 + 64 * h2) = make_uint4(w1[0], w1[1], w1[2], w1[3]);
              } }
            SP_BAR();
            f32x4 acc[8];
#pragma unroll
            for (int ct = 0; ct < 8; ++ct) acc[ct] = (f32x4){0.f, 0.f, 0.f, 0.f};
#pragma unroll
            for (int ks = 0; ks < 4; ++ks) {
                if (ks <= (wid >> 1)) {
                    const float wv[8] = {wa[ks].x, wa[ks].y, wa[ks].z, wa[ks].w, wb[ks].x, wb[ks].y, wb[ks].z, wb[ks].w};
                    const int sb = 32 * ks + 8 * fq;
                    bf16x8 af;
#pragma unroll
                    for (int i = 0; i < 8; ++i) af[i] = (short)f2bf((sb + i) <= t ? wv[i] : 0.f);
#pragma unroll
                    for (int ct = 0; ct < 8; ++ct) {
                        const bf16x8 bfv = *(const bf16x8*)(vnT + (16 * ct + fr) * 136 + 32 * ks + 8 * fq);
                        acc[ct] = __builtin_amdgcn_mfma_f32_16x16x32_bf16(bfv, af, acc[ct], 0, 0, 0);
                    }
                }
            }
#pragma unroll
            for (int ct = 0; ct < 8; ++ct) {
                const uint2 uw = ureg[ct]; const f32x4 uf = (f32x4){bf2f(uw.x & 0xffffu), bf2f(uw.x >> 16), bf2f(uw.y & 0xffffu), bf2f(uw.y >> 16)};
                st_bf4(O + (size_t)(r0 + t) * 1024 + c0 + 16 * ct + 4 * fq, uf * (acc[ct] + bias));
            }
            SP_BAR();
#pragma unroll
            for (int h2 = 0; h2 < 2; ++h2)
#pragma unroll
                for (int s = 0; s < 8; ++s) vcur[h2][s] = vnxt[h2][s];
        }
    }
    if (blockIdx.x < SR) {
        const int i = blockIdx.x, row = P + i; float mu, rstd; rowstat_full(STV, row, mu, rstd);
        float* cvs = p.out + OUT_CVS + (size_t)jb * 128 * 1024 + (size_t)i * 1024;
        const int c = tid * 2, g = c >> 7;
        const unsigned vv = *(const unsigned*)(Vb + (size_t)row * 1024 + c), uu = *(const unsigned*)(U + (size_t)row * 1024 + c);
        const float n0 = (bf2f(vv & 0xffffu) - mu) * rstd * lng[c] + lnb[c], n1 = (bf2f(vv >> 16) - mu) * rstd * lng[c + 1] + lnb[c + 1];
        *(float2*)(cvs + c) = make_float2(n0, n1);
        const float w00 = wsp[(size_t)g * 128 * 128], bb = bsp[g * 128];
        *(unsigned*)(O + (size_t)row * 1024 + c) = cvt_pk_bf16(bf2f(uu & 0xffffu) * (w00 * n0 + bb), bf2f(uu >> 16) * (w00 * n1 + bb));
    }
}

__device__ __forceinline__ void phase_ln_mat(const Params& p, size_t zoff, size_t stoff, const float* g, const float* bb, int nb) {
    const bf16_t* Z = (const bf16_t*)(p.ws + zoff); const float2* ST = (const float2*)(p.ws + stoff); bf16_t* X = (bf16_t*)(p.ws + OFF_X0);
    int tid_ = threadIdx.x; asm volatile("" : "+v"(tid_));
    const int tid = tid_, wid = tid >> 6, lane = tid & 63, bi = (int)gridDim.x - 1 - (int)blockIdx.x;
    if (bi >= nb) return;
    const int c0 = lane * 8;
    const f32x4 g0 = *(const f32x4*)(g + c0), g1 = *(const f32x4*)(g + c0 + 4), g2 = *(const f32x4*)(g + 512 + c0), g3 = *(const f32x4*)(g + 512 + c0 + 4);
    const f32x4 b0 = *(const f32x4*)(bb + c0), b1 = *(const f32x4*)(bb + c0 + 4), b2 = *(const f32x4*)(bb + 512 + c0), b3 = *(const f32x4*)(bb + 512 + c0 + 4);
    for (int row0 = (bi * 8 + wid) * 2; row0 < MT; row0 += nb * 16) {
        float2 pr[2]; uint4 za[2], zb[2];
#pragma unroll
        for (int r = 0; r < 2; ++r) { const int row = row0 + r;
            pr[r] = ST[(size_t)row * 16 + (lane & 15)]; za[r] = *(const uint4*)(Z + (size_t)row * 1024 + c0); zb[r] = *(const uint4*)(Z + (size_t)row * 1024 + 512 + c0); }
#pragma unroll
        for (int r = 0; r < 2; ++r) { const int row = row0 + r;
            float s = pr[r].x, q = pr[r].y;
#pragma unroll
            for (int o = 1; o < 16; o <<= 1) { s += __shfl_xor(s, o); q += __shfl_xor(q, o); }
            float mu, rstd; stat_finish(s, q, mu, rstd);
            const f32x4 z0 = (f32x4){bf2f(za[r].x & 0xffffu), bf2f(za[r].x >> 16), bf2f(za[r].y & 0xffffu), bf2f(za[r].y >> 16)}, z1 = (f32x4){bf2f(za[r].z & 0xffffu), bf2f(za[r].z >> 16), bf2f(za[r].w & 0xffffu), bf2f(za[r].w >> 16)};
            const f32x4 z2 = (f32x4){bf2f(zb[r].x & 0xffffu), bf2f(zb[r].x >> 16), bf2f(zb[r].y & 0xffffu), bf2f(zb[r].y >> 16)}, z3 = (f32x4){bf2f(zb[r].z & 0xffffu), bf2f(zb[r].z >> 16), bf2f(zb[r].w & 0xffffu), bf2f(zb[r].w >> 16)};
            const f32x4 x0 = (z0 - mu) * rstd * g0 + b0, x1 = (z1 - mu) * rstd * g1 + b1, x2 = (z2 - mu) * rstd * g2 + b2, x3 = (z3 - mu) * rstd * g3 + b3;
            uint4 w0, w1; w0.x = cvt_pk_bf16(x0[0], x0[1]); w0.y = cvt_pk_bf16(x0[2], x0[3]); w0.z = cvt_pk_bf16(x1[0], x1[1]); w0.w = cvt_pk_bf16(x1[2], x1[3]);
            w1.x = cvt_pk_bf16(x2[0], x2[1]); w1.y = cvt_pk_bf16(x2[2], x2[3]); w1.z = cvt_pk_bf16(x3[0], x3[1]); w1.w = cvt_pk_bf16(x3[2], x3[3]);
            *(uint4*)(X + (size_t)row * 1024 + c0) = w0; *(uint4*)(X + (size_t)row * 1024 + 512 + c0) = w1;
        }
    }
}

__device__ __forceinline__ void phase_final(const Params& p) {
    const bf16_t* Z = (const bf16_t*)(p.ws + OFF_ZFFN); const float2* STF = (const float2*)(p.ws + OFF_STF);
    const float* g = p.in[5] + 3 * 1024; const float* bb = p.in[6] + 3 * 1024;
    int tid_ = threadIdx.x; asm volatile("" : "+v"(tid_));
    const int tid = tid_, wid = tid >> 6, lane = tid & 63;
    for (int row = blockIdx.x * 8 + wid; row < MT; row += gridDim.x * 8) {
        float s = 0.f, q = 0.f;
        if (lane < 16) { const float2 pr = STF[(size_t)row * 16 + lane]; s = pr.x; q = pr.y; }
#pragma unroll
        for (int o = 1; o < 16; o <<= 1) { s += __shfl_xor(s, o); q += __shfl_xor(q, o); }
        s = __shfl(s, 0); q = __shfl(q, 0);
        float mu, rstd; stat_finish(s, q, mu, rstd);
#pragma unroll
        for (int hf = 0; hf < 2; ++hf) {
            const int c = hf * 512 + lane * 8; const uint4 z8 = *(const uint4*)(Z + (size_t)row * 1024 + c);
            const f32x4 za = (f32x4){bf2f(z8.x & 0xffffu), bf2f(z8.x >> 16), bf2f(z8.y & 0xffffu), bf2f(z8.y >> 16)}, zb = (f32x4){bf2f(z8.z & 0xffffu), bf2f(z8.z >> 16), bf2f(z8.w & 0xffffu), bf2f(z8.w >> 16)};
            float* o = p.out + (size_t)row * 1024 + c;
            *(f32x4*)o = (za - mu) * rstd * *(const f32x4*)(g + c) + *(const f32x4*)(bb + c);
            *(f32x4*)(o + 4) = (zb - mu) * rstd * *(const f32x4*)(g + c + 4) + *(const f32x4*)(bb + c + 4);
        }
    }
}

#define XB_TMO      128
#define XB_XCNT(j)  (256  + 64 * (j))
#define XB_XSUB(j)  (1280 + 64 * (j))
#define XB_XGEN(j)  (2304 + 64 * (j))
#define XB_TOP      3328
#define XB_TOPGEN   3392
#define XCD_BAR_WORDS 3456
#define XB_SPIN_CAP (1u << 18)

__device__ __forceinline__ unsigned xb_ld(unsigned* p)              { return __hip_atomic_load(p, __ATOMIC_RELAXED, __HIP_MEMORY_SCOPE_AGENT); }
__device__ __forceinline__ unsigned xb_add(unsigned* p, unsigned v) { return __hip_atomic_fetch_add(p, v, __ATOMIC_RELAXED, __HIP_MEMORY_SCOPE_AGENT); }
__device__ __forceinline__ unsigned xb_xcc_id() { return (unsigned)__builtin_amdgcn_s_getreg((3 << 11) | 20) & 0xFu; }
#define XB_SPIN(cond, bar) do { unsigned _sp = 0; while (cond) { __builtin_amdgcn_s_sleep(1); \
    if ((++_sp & 255u) == 0u) { if (xb_ld(&(bar)[XB_TMO])) break; if (_sp > XB_SPIN_CAP) { atomicAdd(&(bar)[XB_TMO], 1u); break; } } } } while (0)

struct XcdBarrier {
    unsigned* bar; unsigned x;
    volatile PG8_LAS unsigned* st;
};

__device__ __forceinline__ XcdBarrier xcd_barrier_post(unsigned* bar, volatile PG8_LAS unsigned* st) {
    XcdBarrier b; b.bar = bar; b.x = xb_xcc_id(); b.st = st;
    if (threadIdx.x == 0) (void)xb_add(&bar[XB_XCNT(b.x)], 1u);
    return b;
}
__device__ __forceinline__ void xcd_barrier_complete(unsigned* bar, unsigned x, unsigned& nloc, unsigned& nx) {
    const unsigned G = gridDim.x * gridDim.y * gridDim.z;
    unsigned sum, cnt, mine, sp = 0u;
    for (;;) {
        sum = 0u; cnt = 0u; mine = 0u;
#pragma unroll
        for (unsigned j = 0; j < 16; ++j) { const unsigned c = xb_ld(&bar[XB_XCNT(j)]); sum += c; cnt += (c > 0u) ? 1u : 0u; mine = (j == x) ? c : mine; }
        if (sum == G) break;
        __builtin_amdgcn_s_sleep(1);
        if ((++sp & 255u) == 0u) { if (xb_ld(&bar[XB_TMO])) break; if (sp > XB_SPIN_CAP) { atomicAdd(&bar[XB_TMO], 1u); break; } }
    }
    nloc = mine > 0u ? mine : 1u; nx = cnt > 0u ? cnt : 1u;
}

__device__ __forceinline__ void xcd_barrier(const XcdBarrier& b) {
    asm volatile("s_waitcnt vmcnt(0)" ::: "memory");
    __syncthreads();
    if (threadIdx.x == 0) {
        unsigned* bar = b.bar;
        __builtin_amdgcn_s_waitcnt(0);
        unsigned nloc = b.st[0], nx = b.st[1];
        if (nloc == 0u) { xcd_barrier_complete(bar, b.x, nloc, nx); b.st[0] = nloc; b.st[1] = nx; }
        const unsigned old = xb_add(&bar[XB_XSUB(b.x)], 1u);
        const unsigned gen = old / nloc;
        if (old + 1u == (gen + 1u) * nloc) {
            __builtin_amdgcn_fence(__ATOMIC_RELEASE, "agent");
            asm volatile("s_waitcnt vmcnt(0)" ::: "memory");
            const unsigned og = xb_add(&bar[XB_TOP], 1u);
            const unsigned tg = og / nx;
            if (og + 1u == (tg + 1u) * nx) xb_add(&bar[XB_TOPGEN], 1u);
            else XB_SPIN(xb_ld(&bar[XB_TOPGEN]) == tg, bar);
            __builtin_amdgcn_fence(__ATOMIC_ACQUIRE, "agent");
            xb_add(&bar[XB_XGEN(b.x)], 1u);
            asm volatile("s_waitcnt vmcnt(0)" ::: "memory");
        } else {
            XB_SPIN(xb_ld(&bar[XB_XGEN(b.x)]) == gen, bar);
            __builtin_amdgcn_fence(__ATOMIC_ACQUIRE, "agent");
            asm volatile("s_waitcnt vmcnt(0)" ::: "memory");
        }
    }
    __syncthreads();
}

__global__ void __launch_bounds__(512, 2) hgrn2_chunkmlp_mega(Params p) {
    extern __shared__ __attribute__((aligned(16))) unsigned char shm[];
    cg::grid_group grid = cg::this_grid();
#define WSL(name) unsigned char* name = p.ws; asm volatile("" : "+s"(name))
    unsigned* xb_st = (unsigned*)(shm + 131072);
    if (threadIdx.x < 2) xb_st[threadIdx.x] = 0u;
    if (p.out == nullptr) grid.sync();
    const XcdBarrier xbar = xcd_barrier_post((unsigned*)(p.ws + OFF_BAR), (volatile PG8_LAS unsigned*)xb_st);
    phase_prep(p, shm);
    xcd_barrier(xbar);
#define GRID_SYNC() xcd_barrier(xbar)
#pragma nounroll
    for (int l = 0; l < 4; ++l) {
        const int j = l >> 1;
        if ((l & 1) == 0) {
            WSL(ws);
            pg8::Gemm g; g.A = (const bf16_t*)(ws + (l == 0 ? OFF_X0 : OFF_ZFFN)); g.Bt = (const bf16_t*)(ws + OFF_WT_A_IN) + (size_t)j * 4096 * 1024; g.M = P; g.N = 4096; g.K = 1024;
            Epi e{}; e.stat = l == 0 ? nullptr : (const float2*)(ws + OFF_STF); e.a = (const float*)(ws + OFF_C1_A) + j * 4096; e.b = (const float*)(ws + OFF_C2_A) + j * 4096;
            e.o = (bf16_t*)(ws + OFF_Q); e.x = (const float*)(ws + OFF_LB) + j * 1024;
            run_gemm<0>(shm, g, e);
            GRID_SYNC();
            phase_hgrn_pre(p, shm);
            GRID_SYNC();
            phase_hgrn_prompt(p, shm, j);
            phase_hgrn_sample(p, shm, j);
            GRID_SYNC();
            phase_rms(p, j);
            GRID_SYNC();
        } else {
            WSL(ws);
            pg8::Gemm g; g.A = (const bf16_t*)(ws + OFF_ZFFN); g.Bt = (const bf16_t*)(ws + OFF_WT_B_IN) + (size_t)j * 2048 * 1024; g.M = P; g.N = 2048; g.K = 1024;
            Epi e{}; e.stat = (const float2*)(ws + OFF_STF); e.a = (const float*)(ws + OFF_C1_B) + j * 2048; e.b = (const float*)(ws + OFF_C2_B) + j * 2048;
            e.o = (bf16_t*)(ws + OFF_Q); e.opart = (float2*)(ws + OFF_STV);
            run_gemm<3>(shm, g, e);
            GRID_SYNC();
            phase_spatial(p, shm, j);
            GRID_SYNC();
        }
#pragma nounroll
        for (int r = 0; r < 2; ++r) {
            if (r == 1) {
                WSL(ws);
                pg8::Gemm g; g.A = (const bf16_t*)(ws + OFF_ZMIX); g.Bt = (const bf16_t*)(ws + OFF_WT_F_IN) + (size_t)l * 5632 * 1024; g.M = P; g.N = 5632; g.K = 1024;
                Epi e{}; e.stat = (const float2*)(ws + OFF_STM); e.a = (const float*)(ws + OFF_C1_F) + l * 5632; e.b = (const float*)(ws + OFF_C2_F) + l * 5632; e.o = (bf16_t*)(ws + OFF_H);
                run_gemm<2>(shm, g, e);
                GRID_SYNC();
            }
            WSL(ws);
            pg8::Gemm g; Epi e{}; g.M = P; g.N = 1024;
            if (r == 0) {
                g.A = (const bf16_t*)(ws + OFF_O); g.Bt = (const bf16_t*)(ws + ((l & 1) ? OFF_WT_B_OUT : OFF_WT_A_OUT)) + (size_t)j * 1024 * 1024; g.K = 1024;
                if (l == 0) { e.x = ws + OFF_X0; e.a = (const float*)(ws + OFF_ONES); e.b = (const float*)(ws + OFF_ONES) + 1024; }
                else { e.x = ws + OFF_ZFFN; e.stat = (const float2*)(ws + OFF_STF); e.a = p.in[5] + (l - 1) * 1024; e.b = p.in[6] + (l - 1) * 1024; }
                e.o = (bf16_t*)(ws + OFF_ZMIX); e.opart = (float2*)(ws + OFF_STM);
            } else {
                g.A = (const bf16_t*)(ws + OFF_H); g.Bt = (const bf16_t*)(ws + OFF_WT_F_OUT) + (size_t)l * 1024 * 2816; g.K = 2816;
                e.x = ws + OFF_ZMIX; e.stat = (const float2*)(ws + OFF_STM); e.a = p.in[3] + l * 1024; e.b = p.in[4] + l * 1024;
                e.o = (bf16_t*)(ws + OFF_ZFFN); e.opart = (float2*)(ws + OFF_STF);
            }
            run_gemm<1>(shm, g, e);
            GRID_SYNC();
        }
    }
    phase_final(p);
}

extern "C" void kernel_launch(void* const* d_in, const int* in_sizes, int n_in, void* d_out, int out_size, void* d_ws, size_t ws_size, hipStream_t stream) {
    static int grid = 0;
    if (grid == 0) {
        if (n_in != 19 || ws_size < WS_END) { fprintf(stderr, "kernel_launch: need 19 inputs and %zu bytes of workspace (got %d, %zu)\n", (size_t)WS_END, n_in, ws_size); grid = -1; return; }
        int dev = 0, cus = 0, per_cu = 0;
        hipGetDevice(&dev); hipDeviceGetAttribute(&cus, hipDeviceAttributeMultiprocessorCount, dev);
        if (hipFuncSetAttribute((const void*)hgrn2_chunkmlp_mega, hipFuncAttributeMaxDynamicSharedMemorySize, LDS_BYTES) != hipSuccess) { fprintf(stderr, "kernel_launch: hipFuncSetAttribute failed\n"); grid = -1; return; }
        if (hipOccupancyMaxActiveBlocksPerMultiprocessor(&per_cu, (const void*)hgrn2_chunkmlp_mega, 512, LDS_BYTES) != hipSuccess || per_cu < 1) { fprintf(stderr, "kernel_launch: occupancy query says %d blocks per CU\n", per_cu); grid = -1; return; }
        grid = cus;
        if (grid != 256) { fprintf(stderr, "kernel_launch: built for a 256-CU device (got %d CUs)\n", cus); grid = -1; return; }
    }
    if (grid < 0) return;
    Params p{};
    for (int i = 0; i < 19; ++i) p.in[i] = (const float*)d_in[i];
    p.out = (float*)d_out; p.ws = (unsigned char*)d_ws;
    void* args[] = {&p};
    if (hipMemsetAsync((char*)d_ws + OFF_BAR, 0, 16384, stream) != hipSuccess) { fprintf(stderr, "kernel_launch: hipMemsetAsync of the barrier words failed\n"); return; }
    hipError_t e = hipLaunchCooperativeKernel((void*)hgrn2_chunkmlp_mega, dim3(grid), dim3(512), args, LDS_BYTES, stream);
    if (e != hipSuccess) fprintf(stderr, "cooperative launch failed: %s (grid %d)\n", hipGetErrorString(e), grid);
}
```

```cpp
#include <hip/hip_runtime.h>
#include <hip/hip_cooperative_groups.h>
#include <cstdio>
namespace cg = cooperative_groups;

typedef unsigned short bf16_t;
typedef short bf16x8 __attribute__((ext_vector_type(8)));
typedef float f32x4 __attribute__((ext_vector_type(4)));
typedef float f32x2 __attribute__((ext_vector_type(2)));

constexpr int P = 16384, SR = 128, MT = P + SR, D = 1024, DFF = 2816;
constexpr float ALPHA = 1.681792830507429f;
constexpr float LN_EPS = 1e-5f, RMS_EPS = 1e-6f;
constexpr int LDS_BYTES = 131072 + 64 + 2048;

constexpr size_t al256(size_t x) { return (x + 255) & ~(size_t)255; }
constexpr size_t SZ_ACT = (size_t)MT * D * 2;
constexpr size_t OFF_WT_A_IN = 0;
constexpr size_t OFF_WT_A_OUT = OFF_WT_A_IN + (size_t)2 * 4096 * 1024 * 2;
constexpr size_t OFF_WT_B_IN = OFF_WT_A_OUT + (size_t)2 * 1024 * 1024 * 2;
constexpr size_t OFF_WT_B_OUT = OFF_WT_B_IN + (size_t)2 * 2048 * 1024 * 2;
constexpr size_t OFF_WT_F_IN = OFF_WT_B_OUT + (size_t)2 * 1024 * 1024 * 2;
constexpr size_t OFF_WT_F_OUT = OFF_WT_F_IN + (size_t)4 * 5632 * 1024 * 2;
constexpr size_t OFF_C1_A = OFF_WT_F_OUT + (size_t)4 * 1024 * 2816 * 2;
constexpr size_t OFF_C2_A = OFF_C1_A + 2 * 4096 * 4;
constexpr size_t OFF_C1_B = OFF_C2_A + 2 * 4096 * 4;
constexpr size_t OFF_C2_B = OFF_C1_B + 2 * 2048 * 4;
constexpr size_t OFF_C1_F = OFF_C2_B + 2 * 2048 * 4;
constexpr size_t OFF_C2_F = OFF_C1_F + 4 * 5632 * 4;
constexpr size_t OFF_LB = OFF_C2_F + 4 * 5632 * 4;
constexpr size_t OFF_ONES = OFF_LB + 2 * 1024 * 4;
constexpr size_t OFF_X0 = al256(OFF_ONES + 2 * 1024 * 4);
constexpr size_t OFF_ZMIX = OFF_X0 + SZ_ACT;
constexpr size_t OFF_ZFFN = OFF_ZMIX + SZ_ACT;
constexpr size_t SZ_ST = (size_t)MT * 16 * 8;
constexpr size_t OFF_STM = OFF_ZFFN + SZ_ACT;
constexpr size_t OFF_STF = OFF_STM + SZ_ST;
constexpr size_t OFF_STV = OFF_STF + SZ_ST;
constexpr size_t OFF_Q = OFF_STV + SZ_ST;
constexpr size_t OFF_K = OFF_Q + SZ_ACT;
constexpr size_t OFF_V = OFF_K + SZ_ACT;
constexpr size_t OFF_G = OFF_V + SZ_ACT;
constexpr size_t OFF_O = OFF_G + SZ_ACT;
constexpr size_t OFF_H = OFF_O + SZ_ACT;
constexpr size_t OFF_BAR = al256(OFF_H + (size_t)MT * DFF * 2);
constexpr size_t OFF_AM = OFF_BAR + 16384;
constexpr size_t WS_END = OFF_AM + (size_t)2048 * 4096 * 2;

constexpr size_t OUT_YP = 0, OUT_YS = (size_t)P * D, OUT_HSP = OUT_YS + (size_t)SR * D, OUT_HSS = OUT_HSP + (size_t)2 * 8 * 8 * 16384,
                 OUT_CVP = OUT_HSS + (size_t)2 * 128 * 8 * 16384, OUT_CVS = OUT_CVP + (size_t)2 * 8 * 128 * 1024;

struct Params { const float* in[19]; float* out; unsigned char* ws; };

__device__ __forceinline__ float bf2f(unsigned b) { return __uint_as_float(b << 16); }
__device__ __forceinline__ unsigned short f2bf(float f) { unsigned u = __float_as_uint(f); u += 0x7FFFu + ((u >> 16) & 1u); return (unsigned short)(u >> 16); }
__device__ __forceinline__ unsigned cvt_pk_bf16(float lo, float hi) { unsigned r; asm volatile("v_cvt_pk_bf16_f32 %0, %1, %2" : "=v"(r) : "v"(lo), "v"(hi)); return r; }
__device__ __forceinline__ f32x4 ld_bf4(const bf16_t* p) { const uint2 w = *(const uint2*)p; return (f32x4){bf2f(w.x & 0xffffu), bf2f(w.x >> 16), bf2f(w.y & 0xffffu), bf2f(w.y >> 16)}; }
__device__ __forceinline__ void st_bf4(bf16_t* p, f32x4 v) { uint2 w; w.x = cvt_pk_bf16(v[0], v[1]); w.y = cvt_pk_bf16(v[2], v[3]); *(uint2*)p = w; }
typedef unsigned v4u __attribute__((ext_vector_type(4)));
__device__ __forceinline__ __amdgpu_buffer_rsrc_t wt_rsrc(void* base) { return __builtin_amdgcn_make_buffer_rsrc(base, 0, 0x7ffffff0, 0x00020000); }
__device__ __forceinline__ void st16_wt(__amdgpu_buffer_rsrc_t r, unsigned byteoff, v4u w) { __builtin_amdgcn_raw_buffer_store_b128(w, r, byteoff, 0, 16); }
template <int CTRL> __device__ __forceinline__ float dppf(float x) { return __builtin_bit_cast(float, __builtin_amdgcn_mov_dpp(__builtin_bit_cast(int, x), CTRL, 0xf, 0xf, true)); }

namespace pg8 {
#define PG8_LAS __attribute__((address_space(3)))
constexpr int BM = 256, BK = 64, HALF = 128, HTB = HALF * BK * 2, STAGE_BYTES = 8 * HTB, NXCD = 8, WGM = 8;
__host__ __device__ __forceinline__ int lds_byte(int r, int c) { const int st = (r >> 4) * 2 + (c >> 5), rr = r & 15, cc = c & 31, ob = rr * 64 + cc * 2; return st * 1024 + (ob ^ (((ob >> 9) & 1) << 5)); }
__host__ __device__ __forceinline__ void stage_rc(int b, int& R, int& C) { const int st = b / 1024, sb = b % 1024, swz = sb ^ (((sb >> 9) & 1) << 5); R = (st >> 1) * 16 + swz / 64; C = (st & 1) * 32 + (swz % 64) / 2; }
struct Unit { int pm, pn; };
struct Gemm { const bf16_t* A; const bf16_t* Bt; int M, N, K; };
struct StaticOrder {
    int nM, nN, nwg, G, c;
    __host__ __device__ void init(int M, int N, int G_, int c_) { nM = M / BM; nN = N / BM; nwg = nM * nN; G = G_; c = c_; }
    __host__ __device__ bool next(int i, Unit& u) const {
        const int L = i * G + c; if (L >= nwg) return false;
        const int xcd = L & 7, off = L >> 3;
        u.pm = xcd * 8 + (off & 7); u.pn = off >> 3; return true;
    }
    __device__ __forceinline__ void a_ready(const Unit&) const {}
    __device__ __forceinline__ void done(const Unit&) const {}
};
template <class Epi, class Sched>
__device__ __forceinline__ void gemm_phase(PG8_LAS unsigned char* lds, const Gemm g, const Sched& S, const Epi& E) {
    int tid_ = threadIdx.x; asm volatile("" : "+v"(tid_));
    const int tid = tid_, wid = __builtin_amdgcn_readfirstlane(tid >> 6), lane = tid & 63, wr = wid >> 2, wc = wid & 3, fr = lane & 15, fq = lane >> 4;
    const int K = g.K, nt = K / BK;
    unsigned voffA[2];
#pragma unroll
    for (int i = 0; i < 2; ++i) { int R, C; stage_rc(tid * 16 + i * 8192, R, C); voffA[i] = (unsigned)(R * K + C) * 2u; }
    const size_t kstep = (size_t)(BK * 2);
    const size_t hstep = (size_t)HALF * K * 2;
    const size_t tstep = 2 * hstep;
    const unsigned ldsw = (unsigned)wid * 1024u;
    const int aoff = lds_byte(wr * 64 + fr, fq * 8), boff = lds_byte(wc * 32 + fr, fq * 8);
#define PG8_SA(b, h) (((b) * 2 + (h)) * HTB)
#define PG8_SB(b, h) ((4 + (b) * 2 + (h)) * HTB)
#define PG8_STAGE(bufoff, gbase, voff) do { _Pragma("unroll") for (int _i = 0; _i < 2; ++_i) \
        __builtin_amdgcn_global_load_lds((const unsigned*)((const char*)(gbase) + (voff)[_i]), (PG8_LAS unsigned*)(lds + (bufoff) + ldsw + _i * 8192), 16, 0, 0); } while (0)
#define PG8_LDA(dst, b, h) do { _Pragma("unroll") for (int m = 0; m < 4; ++m) _Pragma("unroll") for (int k = 0; k < 2; ++k) dst[m][k] = *(const PG8_LAS bf16x8*)(lds + PG8_SA(b, h) + aoff + m * 2048 + k * 1024); } while (0)
#define PG8_LDB(dst, b, h) do { _Pragma("unroll") for (int n = 0; n < 2; ++n) _Pragma("unroll") for (int k = 0; k < 2; ++k) dst[n][k] = *(const PG8_LAS bf16x8*)(lds + PG8_SB(b, h) + boff + n * 2048 + k * 1024); } while (0)
#define PG8_MMA(ai, bj, At, Bt) do { __builtin_amdgcn_s_setprio(1); _Pragma("unroll") for (int m = 0; m < 4; ++m) _Pragma("unroll") for (int n = 0; n < 2; ++n) _Pragma("unroll") for (int k = 0; k < 2; ++k) \
        acc[ai][bj][m][n] = __builtin_amdgcn_mfma_f32_16x16x32_bf16(Bt[n][k], At[m][k], acc[ai][bj][m][n], 0, 0, 0); __builtin_amdgcn_s_setprio(0); } while (0)
#define PG8_WAIT_V(n) asm volatile("s_waitcnt vmcnt(" #n ")" ::: "memory")
#define PG8_WAIT_L(n) asm volatile("s_waitcnt lgkmcnt(" #n ")" ::: "memory")
#define PG8_BAR __builtin_amdgcn_s_barrier()
#define PG8_SCHED __builtin_amdgcn_sched_barrier(0)
    Unit cur, nxt; int ui = 0;
    if (!S.next(0, cur)) return;
    f32x4 acc[2][2][4][2];
#pragma unroll
    for (int a = 0; a < 2; ++a)
#pragma unroll
        for (int b = 0; b < 2; ++b)
#pragma unroll
            for (int m = 0; m < 4; ++m)
#pragma unroll
                for (int n = 0; n < 2; ++n) acc[a][b][m][n] = (f32x4){0.f, 0.f, 0.f, 0.f};
    bf16x8 At[4][2], B0[2][2], B1[2][2];
    const char* cA = (const char*)g.A + (size_t)cur.pm * tstep; const char* cB = (const char*)g.Bt + (size_t)cur.pn * tstep;
    S.a_ready(cur);
    PG8_STAGE(PG8_SB(0, 0), cB, voffA); PG8_STAGE(PG8_SA(0, 0), cA, voffA); PG8_STAGE(PG8_SB(0, 1), cB + hstep, voffA); PG8_STAGE(PG8_SA(0, 1), cA + hstep, voffA);
    if (wr == 1) PG8_BAR;
    PG8_WAIT_V(4); PG8_BAR;
    PG8_STAGE(PG8_SB(1, 0), cB + kstep, voffA); PG8_STAGE(PG8_SA(1, 0), cA + kstep, voffA); PG8_STAGE(PG8_SB(1, 1), cB + hstep + kstep, voffA);
    PG8_WAIT_V(6); PG8_BAR;
    for (;;) {
        const bool has_next = S.next(ui + 1, nxt);
        const char* nA = has_next ? (const char*)g.A + (size_t)nxt.pm * tstep : cA; const char* nB = has_next ? (const char*)g.Bt + (size_t)nxt.pn * tstep : cB;
        for (int t = 0; t < nt; t += 2) {
            const bool last = (t == nt - 2);
            const char* a1 = cA + (size_t)(t + 1) * kstep;
            const char* a2 = last ? nA : cA + (size_t)(t + 2) * kstep; const char* b2 = last ? nB : cB + (size_t)(t + 2) * kstep;
            const char* a3 = a2 + kstep; const char* b3 = b2 + kstep;
            if (last && has_next) S.a_ready(nxt);
            PG8_LDB(B0, 0, 0); PG8_SCHED; PG8_LDA(At, 0, 0); PG8_STAGE(PG8_SA(1, 1), a1 + hstep, voffA);
            PG8_WAIT_L(8); PG8_BAR; PG8_WAIT_L(0); PG8_MMA(0, 0, At, B0); PG8_BAR; PG8_SCHED;
            PG8_LDB(B1, 0, 1); PG8_STAGE(PG8_SB(0, 0), b2, voffA);
            PG8_BAR; PG8_WAIT_L(0); PG8_MMA(0, 1, At, B1); PG8_BAR;
            PG8_LDA(At, 0, 1); PG8_STAGE(PG8_SA(0, 0), a2, voffA);
            PG8_BAR; PG8_WAIT_L(0); PG8_MMA(1, 0, At, B0); PG8_BAR; PG8_SCHED;
            PG8_STAGE(PG8_SB(0, 1), b2 + hstep, voffA);
            PG8_WAIT_V(6); PG8_BAR; PG8_MMA(1, 1, At, B1); PG8_BAR;
            PG8_LDB(B0, 1, 0); PG8_SCHED; PG8_LDA(At, 1, 0); PG8_STAGE(PG8_SA(0, 1), a2 + hstep, voffA);
            PG8_WAIT_L(8); PG8_BAR; PG8_WAIT_L(0); PG8_MMA(0, 0, At, B0); PG8_BAR; PG8_SCHED;
            PG8_LDB(B1, 1, 1); PG8_STAGE(PG8_SB(1, 0), b3, voffA);
            PG8_BAR; PG8_WAIT_L(0); PG8_MMA(0, 1, At, B1); PG8_BAR;
            PG8_LDA(At, 1, 1); PG8_STAGE(PG8_SA(1, 0), a3, voffA);
            PG8_BAR; PG8_WAIT_L(0); PG8_MMA(1, 0, At, B0); PG8_BAR; PG8_SCHED;
            PG8_STAGE(PG8_SB(1, 1), b3 + hstep, voffA);
            PG8_WAIT_V(6); PG8_BAR; PG8_MMA(1, 1, At, B1); PG8_BAR;
        }
        E(acc, cur, wr, wc, fr, fq); S.done(cur);
        if (!has_next) break;
#pragma unroll
        for (int a = 0; a < 2; ++a)
#pragma unroll
            for (int b = 0; b < 2; ++b)
#pragma unroll
                for (int m = 0; m < 4; ++m)
#pragma unroll
                    for (int n = 0; n < 2; ++n) acc[a][b][m][n] = (f32x4){0.f, 0.f, 0.f, 0.f};
        cur = nxt; cA = nA; cB = nB; ++ui;
    }
    PG8_WAIT_V(0);
    if (wr == 0) PG8_BAR;
    PG8_BAR;
#undef PG8_SA
#undef PG8_SB
#undef PG8_STAGE
#undef PG8_LDA
#undef PG8_LDB
#undef PG8_MMA
#undef PG8_WAIT_V
#undef PG8_WAIT_L
#undef PG8_BAR
#undef PG8_SCHED
}
}

struct Epi {
    const float2* stat;
    const float* a;
    const float* b;
    bf16_t* o;
    float2* opart;
    const void* x;
};
__device__ __forceinline__ f32x4 sigm4(f32x4 x) { f32x4 r; for (int i = 0; i < 4; ++i) r[i] = __builtin_amdgcn_rcpf(1.0f + __expf(-x[i])); return r; }
__device__ __forceinline__ f32x4 gelu4(f32x4 v) {
    f32x4 o;
#pragma unroll
    for (int i = 0; i < 4; ++i) {
        const float x = v[i], av = fabsf(x), t = __builtin_amdgcn_rcpf(av * 0.2316418882f + 1.0f);
        float q = t * 0.5307027145f + (-0.7265760135f); q = q * t + 0.7107068705f; q = q * t + (-0.142248368f); q = q * t + 0.127414796f; q = q * t;
        const float e = __builtin_amdgcn_exp2f(x * x * (-0.72134752044f));
        const float m = x * (q * e);
        o[i] = x < 0.f ? m : x - m;
    }
    return o;
}
template <int KIND> __device__ __forceinline__ f32x4 epi_val(int col, f32x4 a, float mu, float rstd, f32x4 va, f32x4 vb, f32x4 vx) {
    if constexpr (KIND == 0) {
        const f32x4 val = (a - va * mu) * rstd + vb;
        const int seg = col >> 10;
        if (seg == 0) return val * sigm4(val) * 0.08838834764831845f;
        else if (seg == 1) return (1.0f - vx) * sigm4(-val);
        else if (seg == 2) return val;
        else return val * sigm4(val);
    } else if constexpr (KIND == 1) {
        return ((vx - mu) * rstd * va + vb) * ALPHA + a;
    } else {
        return gelu4((a - va * mu) * rstd + vb);
    }
}
template <int KIND> __device__ __forceinline__ bf16_t* epi_ptr(const Epi& e, int row, int col) {
    if constexpr (KIND == 1) return e.o + (size_t)row * 1024 + col;
    else return e.o + (size_t)(col >> 10) * ((size_t)MT * 1024) + (size_t)row * 1024 + (col & 1023);
}
template <int KIND> __device__ __forceinline__ unsigned epi_off(int row, int col) {
    if constexpr (KIND == 1) return (unsigned)(row * 1024 + col) * 2u;
    else return ((unsigned)(col >> 10) * (unsigned)(MT * 1024) + (unsigned)(row * 1024 + (col & 1023))) * 2u;
}
template <int KIND> __device__ __forceinline__ f32x4 epi_quad(const Epi& e, int row, int col, f32x4 a, float mu, float rstd, f32x4 va, f32x4 vb, f32x4 vx) {
    const f32x4 y = epi_val<KIND>(col, a, mu, rstd, va, vb, vx); st_bf4(epi_ptr<KIND>(e, row, col), y); return y;
}
__device__ __forceinline__ f32x4 epi_val2(f32x4 ga, f32x4 ua, float mu, float rstd, f32x4 c1g, f32x4 c2g, f32x4 c1u, f32x4 c2u) {
    const f32x4 g = (ga - c1g * mu) * rstd + c2g;
    const f32x4 u = (ua - c1u * mu) * rstd + c2u;
    return g * sigm4(g) * u;
}
__device__ __forceinline__ void epi_quad2(const Epi& e, int row, int c, f32x4 ga, f32x4 ua, float mu, float rstd, f32x4 c1g, f32x4 c2g, f32x4 c1u, f32x4 c2u) {
    st_bf4(e.o + (size_t)row * DFF + c, epi_val2(ga, ua, mu, rstd, c1g, c2g, c1u, c2u));
}
__device__ __forceinline__ void st_bf8_wt(__amdgpu_buffer_rsrc_t r, unsigned byteoff, f32x4 y0, f32x4 y1) { v4u w; w.x = cvt_pk_bf16(y0[0], y0[1]); w.y = cvt_pk_bf16(y0[2], y0[3]); w.z = cvt_pk_bf16(y1[0], y1[1]); w.w = cvt_pk_bf16(y1[2], y1[3]); st16_wt(r, byteoff, w); }
__device__ __forceinline__ void stat_finish(float s, float q, float& mu, float& rstd) {
    mu = s * (1.0f / 1024.0f); const float var = fmaxf(q * (1.0f / 1024.0f) - mu * mu, 0.f); rstd = rsqrtf(var + LN_EPS);
}
__device__ __forceinline__ void rowstat_full(const float2* part, int row, float& mu, float& rstd) {
    const float4* pp = (const float4*)(part + (size_t)row * 16); float s = 0.f, q = 0.f;
#pragma unroll
    for (int i = 0; i < 8; ++i) { const float4 a = pp[i]; s += a.x + a.z; q += a.y + a.w; }
    stat_finish(s, q, mu, rstd);
}

constexpr int TAB_OFF = 131072 + 64;
template <int KIND> struct BigEpi {
    Epi e;
    __device__ __forceinline__ void operator()(const f32x4 (&acc)[2][2][4][2], const pg8::Unit& u, int wr, int wc, int fr, int fq) const {
        extern __shared__ __attribute__((aligned(16))) unsigned char shm_[];
        const float2* tab = (const float2*)(shm_ + TAB_OFF);
        const __amdgpu_buffer_rsrc_t orsrc = wt_rsrc(e.o);
        int pc0_ = u.pn * 256 + wc * 32 + fq * 8; asm volatile("" : "+v"(pc0_));
        const int pc0 = pc0_;
        f32x4 va[2][2], vb[2][2], vl[2][2];
#pragma unroll
        for (int bj = 0; bj < 2; ++bj)
#pragma unroll
            for (int n = 0; n < 2; ++n) {
                va[bj][n] = *(const f32x4*)(e.a + pc0 + bj * 128 + n * 4); vb[bj][n] = *(const f32x4*)(e.b + pc0 + bj * 128 + n * 4);
                if (KIND == 0 && (u.pn >> 2) == 1) vl[bj][n] = *(const f32x4*)((const float*)e.x + ((pc0 + bj * 128 + n * 4) & 1023)); else vl[bj][n] = (f32x4){0.f, 0.f, 0.f, 0.f};
            }
        constexpr int GR = (KIND == 3) ? 1 : 2;
#pragma unroll
        for (int g4 = 0; g4 < 8 / GR; ++g4) {
            const int ai = (g4 * GR) >> 2, m0 = (g4 * GR) & 3;
            int rowl_ = ai * 128 + wr * 64 + m0 * 16 + fr; asm volatile("" : "+v"(rowl_));
            const int rowl = rowl_, rowb = u.pm * 256 + rowl;
            uint4 zz[GR][2];
            if constexpr (KIND == 1) {
#pragma unroll
                for (int mm = 0; mm < GR; ++mm)
#pragma unroll
                    for (int bj = 0; bj < 2; ++bj) zz[mm][bj] = *(const uint4*)((const bf16_t*)e.x + (size_t)(rowb + mm * 16) * 1024 + pc0 + bj * 128);
                asm volatile("" ::: "memory");
            }
#pragma unroll
            for (int mm = 0; mm < GR; ++mm) {
                const int row = rowb + mm * 16, m = m0 + mm;
                float mu = 0.f, rstd = 1.f;
                if (e.stat) { const float2 ms = tab[rowl + mm * 16]; mu = ms.x; rstd = ms.y; }
                float s = 0.f, q = 0.f;
                if constexpr (KIND == 2) {
                    const f32x4 y0 = epi_val2(acc[ai][0][m][0], acc[ai][1][m][0], mu, rstd, va[0][0], vb[0][0], va[1][0], vb[1][0]);
                    const f32x4 y1 = epi_val2(acc[ai][0][m][1], acc[ai][1][m][1], mu, rstd, va[0][1], vb[0][1], va[1][1], vb[1][1]);
                    st_bf8_wt(orsrc, (unsigned)(row * DFF + u.pn * 128 + wc * 32 + fq * 8) * 2u, y0, y1);
                } else {
#pragma unroll
                    for (int bj = 0; bj < 2; ++bj) {
                        f32x4 x0 = vl[bj][0], x1 = vl[bj][1];
                        if constexpr (KIND == 1) { const uint4 w = zz[mm][bj]; x0 = (f32x4){bf2f(w.x & 0xffffu), bf2f(w.x >> 16), bf2f(w.y & 0xffffu), bf2f(w.y >> 16)}; x1 = (f32x4){bf2f(w.z & 0xffffu), bf2f(w.z >> 16), bf2f(w.w & 0xffffu), bf2f(w.w >> 16)}; }
                        const int col = pc0 + bj * 128;
                        v4u w;
                        { const f32x4 r0 = epi_val<KIND>(col, acc[ai][bj][m][0], mu, rstd, va[bj][0], vb[bj][0], x0);
                          w.x = cvt_pk_bf16(r0[0], r0[1]); w.y = cvt_pk_bf16(r0[2], r0[3]);
                          s += (r0[0] + r0[1]) + (r0[2] + r0[3]); q += (r0[0] * r0[0] + r0[1] * r0[1]) + (r0[2] * r0[2] + r0[3] * r0[3]); }
                        if constexpr (KIND == 3) __builtin_amdgcn_sched_barrier(0);
                        { const f32x4 r1 = epi_val<KIND>(col, acc[ai][bj][m][1], mu, rstd, va[bj][1], vb[bj][1], x1);
                          w.z = cvt_pk_bf16(r1[0], r1[1]); w.w = cvt_pk_bf16(r1[2], r1[3]);
                          s += (r1[0] + r1[1]) + (r1[2] + r1[3]); q += (r1[0] * r1[0] + r1[1] * r1[1]) + (r1[2] * r1[2] + r1[3] * r1[3]); }
                        st16_wt(orsrc, epi_off<KIND>(row, col), w);
                        if constexpr (KIND == 3) __builtin_amdgcn_sched_barrier(0);
                    }
                }
                if constexpr (KIND == 1 || KIND == 3) {
                    s += __shfl_xor(s, 16); s += __shfl_xor(s, 32); q += __shfl_xor(q, 16); q += __shfl_xor(q, 32);
                    if (fq == 0 && (KIND == 1 || u.pn >= 4)) e.opart[(size_t)row * 16 + (u.pn & 3) * 4 + wc] = make_float2(s, q);
                }
            }
            asm volatile("" ::: "memory");
        }
    }
};

template <int KIND> __device__ __forceinline__ void small_gemm(unsigned char* shm, const bf16_t* A, const bf16_t* Bt, int N, int K, const Epi& e) {
    float* red = (float*)shm;
    int tid_ = threadIdx.x; asm volatile("" : "+v"(tid_));
    const int tid = tid_, wid = tid >> 6, lane = tid & 63, fr = lane & 15, fq = lane >> 4;
    const int ncu = (KIND == 2) ? (N / 256) * 4 : N / 64, nunits = ncu * 4;
    const int nb = (KIND == 2) ? 128 : (int)gridDim.x, bi = (int)gridDim.x - 1 - (int)blockIdx.x;
    for (int unit = bi; unit < nunits && bi < nb; unit += nb) {
        const int ru = unit & 3, cu = unit >> 2, r0 = ru * 32;
        int b0, b1, lcol;
        if (KIND == 2) { const int cb = cu >> 2, cq = cu & 3; b0 = cb * 256 + cq * 32; b1 = b0 + 128; lcol = cb * 128 + cq * 32; }
        else { b0 = cu * 64; b1 = b0 + 32; lcol = b0; }
        const int kw = K >> 3, kbeg = wid * kw;
        f32x4 acc[2][2][2];
#pragma unroll
        for (int t = 0; t < 2; ++t)
#pragma unroll
            for (int i = 0; i < 2; ++i)
#pragma unroll
                for (int j = 0; j < 2; ++j) acc[t][i][j] = (f32x4){0.f, 0.f, 0.f, 0.f};
        const int rr = tid >> 4, jj = tid & 15, row = P + r0 + rr;
        float4 sp[8];
        if (e.stat) { const float4* pp = (const float4*)(e.stat + (size_t)row * 16);
#pragma unroll
            for (int i = 0; i < 8; ++i) sp[i] = pp[i]; }
        const int ecol = (KIND == 2) ? (((lcol + (jj & 7) * 4) >> 7) * 256 + ((lcol + (jj & 7) * 4) & 127)) : (lcol + (jj >> 3) * 32 + (jj & 7) * 4);
        const f32x4 pva = *(const f32x4*)(e.a + ecol), pvb = *(const f32x4*)(e.b + ecol);
        f32x4 pvx = (f32x4){0.f, 0.f, 0.f, 0.f}, pvy = pvx;
        if constexpr (KIND == 2) { pvx = *(const f32x4*)(e.a + ecol + 128); pvy = *(const f32x4*)(e.b + ecol + 128); }
        if constexpr (KIND == 0) { if ((ecol >> 10) == 1) pvx = *(const f32x4*)((const float*)e.x + (ecol & 1023)); }
        if constexpr (KIND == 1) pvx = ld_bf4((const bf16_t*)e.x + (size_t)row * 1024 + ecol);
        const bf16_t* ap = A + (size_t)(P + r0 + fr) * K + kbeg + 8 * fq;
        const bf16_t* bp0 = Bt + (size_t)(b0 + fr) * K + kbeg + 8 * fq;
        const bf16_t* bp1 = Bt + (size_t)(b1 + fr) * K + kbeg + 8 * fq;
        const size_t r16 = (size_t)16 * K;
#pragma unroll 4
        for (int kk = 0; kk < kw; kk += 32) {
            const bf16x8 a0 = *(const bf16x8*)(ap + kk), a1 = *(const bf16x8*)(ap + r16 + kk);
            const bf16x8 b00 = *(const bf16x8*)(bp0 + kk), b01 = *(const bf16x8*)(bp0 + r16 + kk), b10 = *(const bf16x8*)(bp1 + kk), b11 = *(const bf16x8*)(bp1 + r16 + kk);
            acc[0][0][0] = __builtin_amdgcn_mfma_f32_16x16x32_bf16(b00, a0, acc[0][0][0], 0, 0, 0);
            acc[0][0][1] = __builtin_amdgcn_mfma_f32_16x16x32_bf16(b01, a0, acc[0][0][1], 0, 0, 0);
            acc[0][1][0] = __builtin_amdgcn_mfma_f32_16x16x32_bf16(b00, a1, acc[0][1][0], 0, 0, 0);
            acc[0][1][1] = __builtin_amdgcn_mfma_f32_16x16x32_bf16(b01, a1, acc[0][1][1], 0, 0, 0);
            acc[1][0][0] = __builtin_amdgcn_mfma_f32_16x16x32_bf16(b10, a0, acc[1][0][0], 0, 0, 0);
            acc[1][0][1] = __builtin_amdgcn_mfma_f32_16x16x32_bf16(b11, a0, acc[1][0][1], 0, 0, 0);
            acc[1][1][0] = __builtin_amdgcn_mfma_f32_16x16x32_bf16(b10, a1, acc[1][1][0], 0, 0, 0);
            acc[1][1][1] = __builtin_amdgcn_mfma_f32_16x16x32_bf16(b11, a1, acc[1][1][1], 0, 0, 0);
        }
#pragma unroll
        for (int t = 0; t < 2; ++t)
#pragma unroll
            for (int i = 0; i < 2; ++i)
#pragma unroll
                for (int j = 0; j < 2; ++j) *(f32x4*)(red + ((wid * 2 + t) * 32 + 16 * i + fr) * 32 + 8 * fq + 4 * j) = acc[t][i][j];
        __syncthreads();
        float mu = 0.f, rstd = 1.f;
        if (e.stat) { float s = 0.f, q = 0.f;
#pragma unroll
            for (int i = 0; i < 8; ++i) { s += sp[i].x + sp[i].z; q += sp[i].y + sp[i].w; }
            stat_finish(s, q, mu, rstd); }
        if constexpr (KIND == 2) {
            if (jj < 8) {
                const int c4 = jj * 4; f32x4 ga = (f32x4){0.f, 0.f, 0.f, 0.f}, ua = ga;
#pragma unroll
                for (int w = 0; w < 8; ++w) { ga += *(const f32x4*)(red + ((w * 2 + 0) * 32 + rr) * 32 + c4); ua += *(const f32x4*)(red + ((w * 2 + 1) * 32 + rr) * 32 + c4); }
                epi_quad2(e, row, lcol + c4, ga, ua, mu, rstd, pva, pvb, pvx, pvy);
            }
        } else {
            const int t = jj >> 3, c4 = (jj & 7) * 4; f32x4 v = (f32x4){0.f, 0.f, 0.f, 0.f};
#pragma unroll
            for (int w = 0; w < 8; ++w) v += *(const f32x4*)(red + ((w * 2 + t) * 32 + rr) * 32 + c4);
            const f32x4 r = epi_quad<KIND>(e, row, ecol, v, mu, rstd, pva, pvb, pvx);
            if constexpr (KIND == 1 || KIND == 3) {
                float s = (r[0] + r[1]) + (r[2] + r[3]), q = (r[0] * r[0] + r[1] * r[1]) + (r[2] * r[2] + r[3] * r[3]);
                s += __shfl_xor(s, 1); s += __shfl_xor(s, 2); s += __shfl_xor(s, 4); s += __shfl_xor(s, 8);
                q += __shfl_xor(q, 1); q += __shfl_xor(q, 2); q += __shfl_xor(q, 4); q += __shfl_xor(q, 8);
                if (jj == 0 && (KIND == 1 || cu >= 16)) e.opart[(size_t)row * 16 + (cu & 15)] = make_float2(s, q);
            }
        }
        __syncthreads();
    }
}

template <int KIND> __device__ __forceinline__ void run_gemm(unsigned char* shm, const pg8::Gemm& g, const Epi& e) {
    pg8::StaticOrder S; S.init(g.M, g.N, (int)gridDim.x, (int)blockIdx.x);
    BigEpi<KIND> E{e};
    if (e.stat) {
        const int c = (int)blockIdx.x, pm = 8 * (c & 7) + ((c >> 3) & 7);
        if (threadIdx.x < 256) { float mu, rstd; rowstat_full(e.stat, pm * 256 + (int)threadIdx.x, mu, rstd); ((float2*)(shm + TAB_OFF))[threadIdx.x] = make_float2(mu, rstd); }
        __syncthreads();
    }
    pg8::gemm_phase((PG8_LAS unsigned char*)shm, g, S, E);
    __syncthreads();
    small_gemm<KIND>(shm, g.A, g.Bt, g.N, g.K, e);
}

struct MatDesc { const float* src; bf16_t* dst; int K, N; const float* gain; const float* bias; float* c1; float* c2; int swiglu; };
__device__ __forceinline__ int mat_tiles(int id) { return id < 2 ? 64 : id < 4 ? 16 : id < 6 ? 32 : id < 8 ? 16 : id < 12 ? 88 : 16; }
__device__ __forceinline__ void get_mat(const Params& p, int id, MatDesc& m) {
    unsigned char* ws = p.ws; m.gain = nullptr; m.bias = nullptr; m.c1 = nullptr; m.c2 = nullptr; m.swiglu = 0;
    if (id < 2) { const int j = id; m.src = p.in[8] + (size_t)j * 1024 * 4096; m.dst = (bf16_t*)(ws + OFF_WT_A_IN) + (size_t)j * 4096 * 1024; m.K = 1024; m.N = 4096;
        if (j > 0) { m.gain = p.in[5] + (2 * j - 1) * 1024; m.bias = p.in[6] + (2 * j - 1) * 1024; }
        m.c1 = (float*)(ws + OFF_C1_A) + j * 4096; m.c2 = (float*)(ws + OFF_C2_A) + j * 4096; }
    else if (id < 4) { const int j = id - 2; m.src = p.in[10] + (size_t)j * 1024 * 1024; m.dst = (bf16_t*)(ws + OFF_WT_A_OUT) + (size_t)j * 1024 * 1024; m.K = 1024; m.N = 1024; }
    else if (id < 6) { const int j = id - 4; m.src = p.in[11] + (size_t)j * 1024 * 2048; m.dst = (bf16_t*)(ws + OFF_WT_B_IN) + (size_t)j * 2048 * 1024; m.K = 1024; m.N = 2048;
        m.gain = p.in[5] + (2 * j) * 1024; m.bias = p.in[6] + (2 * j) * 1024;
        m.c1 = (float*)(ws + OFF_C1_B) + j * 2048; m.c2 = (float*)(ws + OFF_C2_B) + j * 2048; }
    else if (id < 8) { const int j = id - 6; m.src = p.in[16] + (size_t)j * 1024 * 1024; m.dst = (bf16_t*)(ws + OFF_WT_B_OUT) + (size_t)j * 1024 * 1024; m.K = 1024; m.N = 1024; }
    else if (id < 12) { const int l = id - 8; m.src = p.in[17] + (size_t)l * 1024 * 5632; m.dst = (bf16_t*)(ws + OFF_WT_F_IN) + (size_t)l * 5632 * 1024; m.K = 1024; m.N = 5632;
        m.gain = p.in[3] + l * 1024; m.bias = p.in[4] + l * 1024;
        m.c1 = (float*)(ws + OFF_C1_F) + l * 5632; m.c2 = (float*)(ws + OFF_C2_F) + l * 5632; m.swiglu = 1; }
    else { const int l = id - 12; m.src = p.in[18] + (size_t)l * 2816 * 1024; m.dst = (bf16_t*)(ws + OFF_WT_F_OUT) + (size_t)l * 1024 * 2816; m.K = 2816; m.N = 1024; }
}
__device__ __forceinline__ void phase_prep(const Params& p, unsigned char* shm) {
    int tid_ = threadIdx.x; asm volatile("" : "+v"(tid_)); const int tid = tid_;
    unsigned short* tile = (unsigned short*)shm;
    float* red = (float*)(shm + 64 * 264 * 2);
    for (int task = blockIdx.x; task < 672; task += gridDim.x) {
        int id = 0, t = task; while (t >= mat_tiles(id)) { t -= mat_tiles(id); ++id; }
        MatDesc m; get_mat(p, id, m);
        const int n0 = t * 64;
        int nd0 = n0;
        if (m.swiglu) { const int c = n0 < 2816 ? n0 : n0 - 2816; nd0 = (c >> 7) * 256 + (c & 127) + (n0 < 2816 ? 0 : 128); }
        const int kk = tid >> 4, n4 = (tid & 15) * 4;
        float c1a[4] = {0.f, 0.f, 0.f, 0.f}, c2a[4] = {0.f, 0.f, 0.f, 0.f};
        float4 wq[8]; float gq[8], bq[8];
#pragma unroll
        for (int p8 = 0; p8 < 8; ++p8) { const int k = p8 * 32 + kk; wq[p8] = *(const float4*)(m.src + (size_t)k * m.N + n0 + n4); gq[p8] = m.gain ? m.gain[k] : 1.0f; bq[p8] = m.bias ? m.bias[k] : 0.0f; }
        for (int k0 = 0; k0 < m.K; k0 += 256) {
#pragma unroll
            for (int p8 = 0; p8 < 8; ++p8) {
                const float wv[4] = {wq[p8].x, wq[p8].y, wq[p8].z, wq[p8].w};
#pragma unroll
                for (int i = 0; i < 4; ++i) { const unsigned short r = f2bf(wv[i] * gq[p8]); tile[(n4 + i) * 264 + p8 * 32 + kk] = r; c1a[i] += bf2f(r); c2a[i] += bq[p8] * wv[i]; }
            }
            if (k0 + 256 < m.K) {
#pragma unroll
                for (int p8 = 0; p8 < 8; ++p8) { const int k = k0 + 256 + p8 * 32 + kk; wq[p8] = *(const float4*)(m.src + (size_t)k * m.N + n0 + n4); gq[p8] = m.gain ? m.gain[k] : 1.0f; bq[p8] = m.bias ? m.bias[k] : 0.0f; }
            }
            asm volatile("s_waitcnt lgkmcnt(0)" ::: "memory"); __builtin_amdgcn_s_barrier(); asm volatile("" ::: "memory");
            const int n = tid >> 3, cl = n & 31, nrow = (n & 32) + 16 * ((cl >> 2) & 1) + 4 * (cl >> 3) + (cl & 3);
#pragma unroll
            for (int p2 = 0; p2 < 4; ++p2) { const int k8 = (tid & 7) * 8 + p2 * 64; const uint4 v = *(const uint4*)&tile[n * 264 + k8]; *(uint4*)(m.dst + (size_t)(nd0 + nrow) * m.K + k0 + k8) = v; }
            asm volatile("s_waitcnt lgkmcnt(0)" ::: "memory"); __builtin_amdgcn_s_barrier(); asm volatile("" ::: "memory");
        }
        if (m.c1) {
#pragma unroll
            for (int i = 0; i < 4; ++i) { red[(0 * 32 + kk) * 64 + n4 + i] = c1a[i]; red[(1 * 32 + kk) * 64 + n4 + i] = c2a[i]; }
            __syncthreads();
            if (tid < 128) { const int which = tid >> 6, n = tid & 63; float s = 0.f; for (int k2 = 0; k2 < 32; ++k2) s += red[(which * 32 + k2) * 64 + n]; (which ? m.c2 : m.c1)[nd0 + n] = s; }
            __syncthreads();
        }
    }
    bf16_t* X0 = (bf16_t*)(p.ws + OFF_X0);
    for (size_t i = (size_t)blockIdx.x * 512 + tid; i < (size_t)MT * 256; i += (size_t)gridDim.x * 512) {
        const size_t e0 = i * 4; const float* src = e0 < (size_t)P * D ? p.in[0] + e0 : p.in[1] + (e0 - (size_t)P * D);
        st_bf4(X0 + e0, *(const f32x4*)src);
    }
    if (blockIdx.x == 0) {
        float* LB = (float*)(p.ws + OFF_LB);
        for (int c = tid; c < 1024; c += 512) {
            const float r0 = p.in[7][c], r1 = p.in[7][1024 + c], r2 = p.in[7][2048 + c], r3 = p.in[7][3072 + c];
            const float mx = fmaxf(fmaxf(r0, r1), fmaxf(r2, r3));
            const float e0 = expf(r0 - mx), e1 = expf(r1 - mx), e2 = expf(r2 - mx), e3 = expf(r3 - mx);
            LB[c] = 0.f; LB[1024 + c] = (e1 + e2) / (e0 + e1 + e2 + e3);
            float* ONES = (float*)(p.ws + OFF_ONES); ONES[c] = 1.0f; ONES[1024 + c] = 0.0f;
        }
    }
}

__device__ __forceinline__ void unpack8(const uint4 r, float* d) {
    *(float4*)d = make_float4(bf2f(r.x & 0xffffu), bf2f(r.x >> 16), bf2f(r.y & 0xffffu), bf2f(r.y >> 16));
    *(float4*)(d + 4) = make_float4(bf2f(r.z & 0xffffu), bf2f(r.z >> 16), bf2f(r.w & 0xffffu), bf2f(r.w >> 16));
}
__device__ __forceinline__ void phase_hgrn_pre(const Params& p, unsigned char* shm) {
    bf16_t* RAWq = (bf16_t*)shm;
    bf16_t* RAWk = RAWq + 64 * 128;
    bf16_t* Qm = RAWk + 64 * 128;
    bf16_t* Km = Qm + 64 * 136;
    bf16_t* KmT = Km + 64 * 136;
    bf16_t* AmL = KmT + 128 * 72;
    float* tot = (float*)(AmL + 64 * 72);
    bf16_t* Q = (bf16_t*)(p.ws + OFF_Q); const bf16_t* Kb = (const bf16_t*)(p.ws + OFF_K); bf16_t* KT = (bf16_t*)(p.ws + OFF_ZMIX); float* EV = (float*)(p.ws + OFF_STM);
    bf16_t* AM = (bf16_t*)(p.ws + OFF_AM);
    int tid_ = threadIdx.x; asm volatile("" : "+v"(tid_));
    const int tid = tid_, tq = tid >> 7, kcol = tid & 127, lt = tid >> 3, lseg = (tid & 7) * 16, wid = tid >> 6, lane = tid & 63, fr = lane & 15, fq = lane >> 4;
#define PRE_BAR() do { asm volatile("s_waitcnt lgkmcnt(0)" ::: "memory"); __builtin_amdgcn_s_barrier(); asm volatile("" ::: "memory"); } while (0)
    uint4 nq0, nq1, nk0, nk1;
    { const int it0 = (int)blockIdx.x, c0 = it0 & 31, h0 = (it0 >> 5) & 7, b0 = it0 >> 8; const size_t g0 = (size_t)(b0 * 2048 + c0 * 64 + lt) * 1024 + h0 * 128 + lseg;
      nq0 = *(const uint4*)(Q + g0); nq1 = *(const uint4*)(Q + g0 + 8); nk0 = *(const uint4*)(Kb + g0); nk1 = *(const uint4*)(Kb + g0 + 8); }
    for (int item = blockIdx.x; item < 2048; item += gridDim.x) {
        const int c = item & 31, h = (item >> 5) & 7, b = item >> 8;
        const size_t goff = (size_t)(b * 2048 + c * 64 + lt) * 1024 + h * 128 + lseg;
        *(uint4*)(RAWq + lt * 128 + lseg) = nq0; *(uint4*)(RAWq + lt * 128 + lseg + 8) = nq1;
        *(uint4*)(RAWk + lt * 128 + lseg) = nk0; *(uint4*)(RAWk + lt * 128 + lseg + 8) = nk1;
        { const int itn = item + (int)gridDim.x;
          if (itn < 2048) { const int cn = itn & 31, hn = (itn >> 5) & 7, bn = itn >> 8; const size_t gn = (size_t)(bn * 2048 + cn * 64 + lt) * 1024 + hn * 128 + lseg;
            nq0 = *(const uint4*)(Q + gn); nq1 = *(const uint4*)(Q + gn + 8); nk0 = *(const uint4*)(Kb + gn); nk1 = *(const uint4*)(Kb + gn + 8); } }
        PRE_BAR();
        float lf[16], kv[16]; float cs = 0.f;
#pragma unroll
        for (int i = 0; i < 16; ++i) { kv[i] = bf2f(RAWk[(16 * tq + i) * 128 + kcol]); lf[i] = __builtin_amdgcn_logf(fmaxf(1.0f - kv[i], 1e-6f)); cs += lf[i]; }
        tot[tq * 128 + kcol] = cs;
        PRE_BAR();
        {
            const float t0 = tot[kcol], t1 = tot[128 + kcol], t2 = tot[256 + kcol], t3 = tot[384 + kcol];
            float g = (tq > 0 ? t0 : 0.f) + (tq > 1 ? t1 : 0.f) + (tq > 2 ? t2 : 0.f);
            const float gmid = t0 + t1;
            if (tq == 0) { float* ev = EV + (size_t)(b * 32 + c) * 1024 + h * 128 + kcol; ev[0] = __builtin_amdgcn_exp2f(gmid); ev[262144] = __builtin_amdgcn_exp2f(t2 + t3); }
            unsigned kmt[8];
#pragma unroll
            for (int i = 0; i < 16; i += 2) {
                const int t = 16 * tq + i;
                const float ga = g + lf[i], gb = ga + lf[i + 1]; g = gb;
                const float qa = bf2f(RAWq[t * 128 + kcol]), qb = bf2f(RAWq[(t + 1) * 128 + kcol]);
                const unsigned pq = cvt_pk_bf16(qa * __builtin_amdgcn_exp2f(fminf(ga - gmid, 126.f)), qb * __builtin_amdgcn_exp2f(fminf(gb - gmid, 126.f)));
                const unsigned pk = cvt_pk_bf16(kv[i] * __builtin_amdgcn_exp2f(fminf(gmid - ga, 126.f)), kv[i + 1] * __builtin_amdgcn_exp2f(fminf(gmid - gb, 126.f)));
                Qm[t * 136 + kcol] = (bf16_t)(pq & 0xffffu); Qm[(t + 1) * 136 + kcol] = (bf16_t)(pq >> 16);
                Km[t * 136 + kcol] = (bf16_t)(pk & 0xffffu); Km[(t + 1) * 136 + kcol] = (bf16_t)(pk >> 16);
                kmt[i >> 1] = pk;
            }
            *(uint4*)(KmT + kcol * 72 + 16 * tq) = make_uint4(kmt[0], kmt[1], kmt[2], kmt[3]);
            *(uint4*)(KmT + kcol * 72 + 16 * tq + 8) = make_uint4(kmt[4], kmt[5], kmt[6], kmt[7]);
        }
        PRE_BAR();
#pragma unroll
        for (int hf = 0; hf < 2; ++hf) {
            const int idx = wid + 8 * hf, tt = idx >> 2, st = idx & 3;
            f32x4 a = (f32x4){0.f, 0.f, 0.f, 0.f};
            if (st <= tt) {
#pragma unroll
                for (int k4 = 0; k4 < 4; ++k4) {
                    const bf16x8 X = *(const bf16x8*)(Km + (16 * st + fr) * 136 + 32 * k4 + 8 * fq), Y = *(const bf16x8*)(Qm + (16 * tt + fr) * 136 + 32 * k4 + 8 * fq);
                    a = __builtin_amdgcn_mfma_f32_16x16x32_bf16(X, Y, a, 0, 0, 0);
                }
            }
            const int t = 16 * tt + fr;
#pragma unroll
            for (int r = 0; r < 4; ++r) if (16 * st + 4 * fq + r > t) a[r] = 0.f;
            st_bf4(AmL + t * 72 + 16 * st + 4 * fq, a);
        }
        PRE_BAR();
        *(uint4*)(Q + goff) = *(const uint4*)(Qm + lt * 136 + lseg); *(uint4*)(Q + goff + 8) = *(const uint4*)(Qm + lt * 136 + lseg + 8);
        { const int kk = tid >> 2, sg = (tid & 3) * 16; bf16_t* dst = KT + (size_t)item * 8192 + kk * 64 + sg;
          *(uint4*)dst = *(const uint4*)(KmT + kk * 72 + sg); *(uint4*)(dst + 8) = *(const uint4*)(KmT + kk * 72 + sg + 8); }
        *(uint4*)(AM + (size_t)item * 4096 + lt * 64 + (tid & 7) * 8) = *(const uint4*)(AmL + lt * 72 + (tid & 7) * 8);
        PRE_BAR();
    }
#undef PRE_BAR
}
__device__ __forceinline__ void phase_hgrn_prompt(const Params& p, unsigned char* shm, int j) {
    constexpr int SET = 64 * 136 + 128 * 72 + 64 * 72 + 32 * 72 + 32 * 136;
    const bf16_t* Q = (const bf16_t*)(p.ws + OFF_Q); const bf16_t* Vb = (const bf16_t*)(p.ws + OFF_V);
    const bf16_t* KT = (const bf16_t*)(p.ws + OFF_ZMIX); const float* EV = (const float*)(p.ws + OFF_STM); const bf16_t* AM = (const bf16_t*)(p.ws + OFF_AM);
    float* ORAW = (float*)(p.ws + OFF_H);
    int tid_ = threadIdx.x; asm volatile("" : "+v"(tid_));
    const int tid = tid_, wid = tid >> 6, lane = tid & 63, fr = lane & 15, fq = lane >> 4;
    const int lt = tid >> 3, lseg = (tid & 7) * 16, kk = tid >> 2, sg = (tid & 3) * 16, ks4 = 16 * wid + 4 * fq;
    for (int task = blockIdx.x; task < 256; task += gridDim.x) {
        const int bh = (task & 7) * 8 + (task >> 5), vq = (task >> 3) & 3, b = bh >> 3, h = bh & 7, rowbase = b * 2048;
        f32x4 S[2]; S[0] = (f32x4){0.f, 0.f, 0.f, 0.f}; S[1] = S[0];
        uint4 RA_q0, RA_q1, RA_t0, RA_t1, RA_a, RA_v = make_uint4(0, 0, 0, 0), RB_q0, RB_q1, RB_t0, RB_t1, RB_a, RB_v = make_uint4(0, 0, 0, 0);
        f32x4 RA_em, RA_ee, RB_em, RB_ee;
#define HG_LOAD(cc, R) do { \
            const size_t off = (size_t)(rowbase + (cc) * 64 + lt) * 1024 + h * 128 + lseg; \
            R##_q0 = *(const uint4*)(Q + off); R##_q1 = *(const uint4*)(Q + off + 8); \
            const bf16_t* kt = KT + (size_t)(bh * 32 + (cc)) * 8192 + kk * 64 + sg; R##_t0 = *(const uint4*)kt; R##_t1 = *(const uint4*)(kt + 8); \
            R##_a = *(const uint4*)(AM + (size_t)(bh * 32 + (cc)) * 4096 + lt * 64 + (tid & 7) * 8); \
            if (tid < 256) R##_v = *(const uint4*)(Vb + (size_t)(rowbase + (cc) * 64 + (tid >> 2)) * 1024 + h * 128 + vq * 32 + (tid & 3) * 8); \
            const float* ev = EV + (size_t)(b * 32 + (cc)) * 1024 + h * 128 + ks4; R##_em = *(const f32x4*)ev; R##_ee = *(const f32x4*)(ev + 262144); \
} while (0)
#define HG_BODY(c, R) do { \
            bf16_t* Qm = (bf16_t*)shm + ((c) & 1) * SET; bf16_t* KmT = Qm + 64 * 136; bf16_t* Am = KmT + 128 * 72; bf16_t* VT = Am + 64 * 72; bf16_t* SpT = VT + 32 * 72; \
            *(uint4*)(Qm + lt * 136 + lseg) = R##_q0; *(uint4*)(Qm + lt * 136 + lseg + 8) = R##_q1; \
            *(uint4*)(KmT + kk * 72 + sg) = R##_t0; *(uint4*)(KmT + kk * 72 + sg + 8) = R##_t1; \
            *(uint4*)(Am + lt * 72 + (tid & 7) * 8) = R##_a; \
            if (tid < 256) { const int t = tid >> 2, c8 = (tid & 3) * 8; const unsigned w[4] = {R##_v.x, R##_v.y, R##_v.z, R##_v.w}; \
_Pragma("unroll") \
                for (int i = 0; i < 4; ++i) { VT[(c8 + 2 * i) * 72 + t] = (bf16_t)(w[i] & 0xffffu); VT[(c8 + 2 * i + 1) * 72 + t] = (bf16_t)(w[i] >> 16); } } \
            const f32x4 e_mid = R##_em, e_em = R##_ee, e_end = R##_em * R##_ee; \
_Pragma("unroll") \
            for (int it = 0; it < 2; ++it) { \
                st_bf4(SpT + (16 * it + fr) * 136 + ks4, e_mid * S[it]); } \
            asm volatile("s_waitcnt lgkmcnt(0)" ::: "memory"); __builtin_amdgcn_s_barrier(); asm volatile("" ::: "memory"); \
            if ((c) + 2 < 32) HG_LOAD(((c)) + 2, R); \
              \
            const int it = wid >> 2, tt = wid & 3; \
            bf16x8 YQ[4], XO[4], XS0[2], XS1[2], YS[2], YA[2]; \
_Pragma("unroll") \
            for (int k4 = 0; k4 < 4; ++k4) { \
                YQ[k4] = *(const bf16x8*)(Qm + (16 * tt + fr) * 136 + 32 * k4 + 8 * fq); XO[k4] = *(const bf16x8*)(SpT + (16 * it + fr) * 136 + 32 * k4 + 8 * fq); } \
_Pragma("unroll") \
            for (int k2 = 0; k2 < 2; ++k2) { XS0[k2] = *(const bf16x8*)(VT + (fr) * 72 + 32 * k2 + 8 * fq); XS1[k2] = *(const bf16x8*)(VT + (16 + fr) * 72 + 32 * k2 + 8 * fq); \
                YS[k2] = *(const bf16x8*)(KmT + (16 * wid + fr) * 72 + 32 * k2 + 8 * fq); YA[k2] = *(const bf16x8*)(Am + (16 * tt + fr) * 72 + 32 * k2 + 8 * fq); } \
            f32x4 o = (f32x4){0.f, 0.f, 0.f, 0.f}, d0 = o, d1 = o; \
_Pragma("unroll") \
            for (int k4 = 0; k4 < 4; ++k4) { \
                o = __builtin_amdgcn_mfma_f32_16x16x32_bf16(XO[k4], YQ[k4], o, 0, 0, 0); \
                if (k4 < 2) { d0 = __builtin_amdgcn_mfma_f32_16x16x32_bf16(YS[k4], XS0[k4], d0, 0, 0, 0); d1 = __builtin_amdgcn_mfma_f32_16x16x32_bf16(YS[k4], XS1[k4], d1, 0, 0, 0); \
                              o = __builtin_amdgcn_mfma_f32_16x16x32_bf16(it ? XS1[k4] : XS0[k4], YA[k4], o, 0, 0, 0); } } \
            S[0] = S[0] * e_end + d0 * e_em; S[1] = S[1] * e_end + d1 * e_em; \
            *(f32x4*)(ORAW + (size_t)(rowbase + (c) * 64 + 16 * tt + fr) * 1024 + h * 128 + vq * 32 + 16 * it + 4 * fq) = o; \
} while (0)
        HG_LOAD(0, RA); HG_LOAD(1, RB);
#pragma nounroll
        for (int c = 0; c < 32; c += 2) { const int c1 = c + 1; HG_BODY(c, RA); HG_BODY(c1, RB); }
#undef HG_LOAD
#undef HG_BODY
        float* so = p.out + OUT_HSP + ((size_t)((j * 8 + b) * 8 + h) * 128) * 128;
#pragma unroll
        for (int i2 = 0; i2 < 2; ++i2)
#pragma unroll
            for (int r = 0; r < 4; ++r) so[(size_t)(ks4 + r) * 128 + vq * 32 + 16 * i2 + fr] = S[i2][r];
        __syncthreads();
    }
}
__device__ __forceinline__ void phase_hgrn_sample(const Params& p, unsigned char* shm, int j) {
    float* qs = (float*)shm; float* ks = qs + 128; float* red = ks + 128; float* ssq = red + 16 * 128;
    const bf16_t* Q = (const bf16_t*)(p.ws + OFF_Q); const bf16_t* Kb = (const bf16_t*)(p.ws + OFF_K); const bf16_t* Vb = (const bf16_t*)(p.ws + OFF_V); const bf16_t* G = (const bf16_t*)(p.ws + OFF_G);
    bf16_t* O = (bf16_t*)(p.ws + OFF_O);
    int tid_ = threadIdx.x; asm volatile("" : "+v"(tid_));
    const int tid = tid_, c4 = (tid & 31) * 4, kr = tid >> 5;
    for (int task = blockIdx.x; task < 1024; task += gridDim.x) {
        const int b = task >> 3, h = task & 7; const size_t rowoff = (size_t)(P + b) * 1024 + h * 128;
        if (tid < 128) { qs[tid] = bf2f(Q[rowoff + tid]); ks[tid] = bf2f(Kb[rowoff + tid]); }
        const f32x4 v4 = ld_bf4(Vb + rowoff + c4);
        __syncthreads();
        const float* Sin = p.in[2] + ((size_t)(j * 128 + b) * 8 + h) * 16384; float* Sout = p.out + OUT_HSS + ((size_t)(j * 128 + b) * 8 + h) * 16384;
        f32x4 o4 = (f32x4){0.f, 0.f, 0.f, 0.f};
#pragma unroll
        for (int i = 0; i < 8; ++i) { const int k = kr + 16 * i; f32x4 s = *(const f32x4*)(Sin + k * 128 + c4); s = s + (v4 - s) * ks[k]; *(f32x4*)(Sout + k * 128 + c4) = s; o4 += s * qs[k]; }
        *(f32x4*)(red + kr * 128 + c4) = o4;
        __syncthreads();
        float o = 0.f;
        if (tid < 128) {
#pragma unroll
            for (int r = 0; r < 16; ++r) o += red[r * 128 + tid];
            float ss = o * o;
#pragma unroll
            for (int off = 1; off < 64; off <<= 1) ss += __shfl_xor(ss, off);
            if ((tid & 63) == 0) ssq[tid >> 6] = ss;
        }
        __syncthreads();
        if (tid < 128) {
            const float r = rsqrtf((ssq[0] + ssq[1]) * (1.0f / 128.0f) + RMS_EPS);
            O[rowoff + tid] = f2bf(o * r * p.in[9][j * 128 + tid] * bf2f(G[rowoff + tid]));
        }
        __syncthreads();
    }
}
__device__ __forceinline__ void phase_rms(const Params& p, int j) {
    const float* ORAW = (const float*)(p.ws + OFF_H); const bf16_t* G = (const bf16_t*)(p.ws + OFF_G); bf16_t* O = (bf16_t*)(p.ws + OFF_O);
    int tid_ = threadIdx.x; asm volatile("" : "+v"(tid_)); const int tid = tid_;
    const f32x4 ng = *(const f32x4*)(p.in[9] + j * 128 + (tid & 31) * 4);
    for (int it0 = blockIdx.x; it0 < P * 8 / 16; it0 += 4 * gridDim.x) {
        f32x4 o4[4]; uint2 gw[4]; size_t off[4]; bool ok[4];
#pragma unroll
        for (int u = 0; u < 4; ++u) {
            const int it = it0 + u * (int)gridDim.x; ok[u] = it < P * 8 / 16;
            const int pair = (ok[u] ? it : it0) * 16 + (tid >> 5), row = pair >> 3, h = pair & 7; off[u] = (size_t)row * 1024 + h * 128 + (tid & 31) * 4;
            o4[u] = *(const f32x4*)(ORAW + off[u]); gw[u] = *(const uint2*)(G + off[u]);
        }
#pragma unroll
        for (int u = 0; u < 4; ++u) {
            float ss = (o4[u][0] * o4[u][0] + o4[u][1] * o4[u][1]) + (o4[u][2] * o4[u][2] + o4[u][3] * o4[u][3]);
#pragma unroll
            for (int o = 1; o < 32; o <<= 1) ss += __shfl_xor(ss, o);
            const float r = rsqrtf(ss * (1.0f / 128.0f) + RMS_EPS);
            const f32x4 gf = (f32x4){bf2f(gw[u].x & 0xffffu), bf2f(gw[u].x >> 16), bf2f(gw[u].y & 0xffffu), bf2f(gw[u].y >> 16)};
            if (ok[u]) st_bf4(O + off[u], o4[u] * r * ng * gf);
        }
    }
}

#define SP_BAR() do { asm volatile("s_waitcnt lgkmcnt(0)" ::: "memory"); __builtin_amdgcn_s_barrier(); asm volatile("" ::: "memory"); } while (0)
__device__ __forceinline__ void phase_spatial(const Params& p, unsigned char* shm, int jb) {
    bf16_t* vnT = (bf16_t*)shm;
    float2* st = (float2*)(shm + 128 * 136 * 2);
    const bf16_t* U = (const bf16_t*)(p.ws + OFF_Q); const bf16_t* Vb = (const bf16_t*)(p.ws + OFF_K); bf16_t* O = (bf16_t*)(p.ws + OFF_O);
    const float2* STV = (const float2*)(p.ws + OFF_STV);
    const float* lng = p.in[12] + jb * 1024; const float* lnb = p.in[13] + jb * 1024; const float* wsp = p.in[14] + (size_t)jb * 8 * 128 * 128; const float* bsp = p.in[15] + jb * 8 * 128;
    float* cvp = p.out + OUT_CVP + (size_t)jb * 8 * 128 * 1024;
    int tid_ = threadIdx.x; asm volatile("" : "+v"(tid_));
    const int tid = tid_, wid = tid >> 6, lane = tid & 63, fr = lane & 15, fq = lane >> 4;
    for (int task = blockIdx.x; task < 256; task += gridDim.x) {
        const int gh = task & 1, cn = task >> 1, b = cn >> 4, n = cn & 15, r0 = b * 2048 + n * 128;
        if (tid < 128) { float mu, rstd; rowstat_full(STV, r0 + tid, mu, rstd); st[tid] = make_float2(mu, rstd); }
        __syncthreads();
        const int ic = (tid & 63) * 2, is8 = (tid >> 6) * 8;
        const int t = 16 * wid + fr;
        unsigned vcur[2][8], vnxt[2][8];
#pragma unroll
        for (int h2 = 0; h2 < 2; ++h2)
#pragma unroll
            for (int s = 0; s < 8; ++s) { vcur[h2][s] = *(const unsigned*)(Vb + (size_t)(r0 + is8 + 64 * h2 + s) * 1024 + gh * 512 + ic); vnxt[h2][s] = 0u; }
        for (int gi = 0; gi < 4; ++gi) {
            const int g = gh * 4 + gi, c0 = g * 128;
            float4 wa[4], wb[4]; uint2 ureg[8];
#pragma unroll
            for (int ks = 0; ks < 4; ++ks) { const float* wp = wsp + ((size_t)g * 128 + t) * 128 + 32 * ks + 8 * fq; wa[ks] = *(const float4*)wp; wb[ks] = *(const float4*)(wp + 4); }
#pragma unroll
            for (int ct = 0; ct < 8; ++ct) ureg[ct] = *(const uint2*)(U + (size_t)(r0 + t) * 1024 + c0 + 16 * ct + 4 * fq);
            const float bias = bsp[g * 128 + t];
            if (gi < 3) {
#pragma unroll
                for (int h2 = 0; h2 < 2; ++h2)
#pragma unroll
                    for (int s = 0; s < 8; ++s) vnxt[h2][s] = *(const unsigned*)(Vb + (size_t)(r0 + is8 + 64 * h2 + s) * 1024 + c0 + 128 + ic);
            }
            { const float g0 = lng[c0 + ic], g1 = lng[c0 + ic + 1], b0 = lnb[c0 + ic], b1 = lnb[c0 + ic + 1];
#pragma unroll
              for (int h2 = 0; h2 < 2; ++h2) {
                unsigned w0[4], w1[4];
#pragma unroll
                for (int s2 = 0; s2 < 4; ++s2) {
                    float a0[2], a1[2];
#pragma unroll
                    for (int e = 0; e < 2; ++e) {
                        const int s = is8 + 64 * h2 + s2 * 2 + e; const unsigned vv = vcur[h2][s2 * 2 + e]; const float2 ms = st[s];
                        a0[e] = (bf2f(vv & 0xffffu) - ms.x) * ms.y * g0 + b0; a1[e] = (bf2f(vv >> 16) - ms.x) * ms.y * g1 + b1;
                        if (n == 15) *(float2*)(cvp + ((size_t)(b * 128 + s)) * 1024 + c0 + ic) = make_float2(a0[e], a1[e]);
                    }
                    w0[s2] = cvt_pk_bf16(a0[0], a0[1]); w1[s2] = cvt_pk_bf16(a1[0], a1[1]);
                }
                *(uint4*)(vnT + ic * 136 + is8 + 64 * h2) = make_uint4(w0[0], w0[1], w0[2], w0[3]);
                *(uint4*)(vnT + (ic + 1) * 136 + is8 + 64 * h2) = make_uint4(w1[0], w1[1], w1[2], w1[3]);
              } }
            SP_BAR();
            f32x4 acc[8];
#pragma unroll
            for (int ct = 0; ct < 8; ++ct) acc[ct] = (f32x4){0.f, 0.f, 0.f, 0.f};
#pragma unroll
            for (int ks = 0; ks < 4; ++ks) {
                if (ks <= (wid >> 1)) {
                    const float wv[8] = {wa[ks].x, wa[ks].y, wa[ks].z, wa[ks].w, wb[ks].x, wb[ks].y, wb[ks].z, wb[ks].w};
                    const int sb = 32 * ks + 8 * fq;
                    bf16x8 af;
#pragma unroll
                    for (int i = 0; i < 8; ++i) af[i] = (short)f2bf((sb + i) <= t ? wv[i] : 0.f);
#pragma unroll
                    for (int ct = 0; ct < 8; ++ct) {
                        const bf16x8 bfv = *(const bf16x8*)(vnT + (16 * ct + fr) * 136 + 32 * ks + 8 * fq);
                        acc[ct] = __builtin_amdgcn_mfma_f32_16x16x32_bf16(bfv, af, acc[ct], 0, 0, 0);
                    }
                }
            }
#pragma unroll
            for (int ct = 0; ct < 8; ++ct) {
                const uint2 uw = ureg[ct]; const f32x4 uf = (f32x4){bf2f(uw.x & 0xffffu), bf2f(uw.x >> 16), bf2f(uw.y & 0xffffu), bf2f(uw.y >> 16)};
                st_bf4(O + (size_t)(r0 + t) * 1024 + c0 + 16 * ct + 4 * fq, uf * (acc[ct] + bias));
            }
            SP_BAR();
#pragma unroll
            for (int h2 = 0; h2 < 2; ++h2)
#pragma unroll
                for (int s = 0; s < 8; ++s) vcur[h2][s] = vnxt[h2][s];
        }
    }
    if (blockIdx.x < SR) {
        const int i = blockIdx.x, row = P + i; float mu, rstd; rowstat_full(STV, row, mu, rstd);
        float* cvs = p.out + OUT_CVS + (size_t)jb * 128 * 1024 + (size_t)i * 1024;
        const int c = tid * 2, g = c >> 7;
        const unsigned vv = *(const unsigned*)(Vb + (size_t)row * 1024 + c), uu = *(const unsigned*)(U + (size_t)row * 1024 + c);
        const float n0 = (bf2f(vv & 0xffffu) - mu) * rstd * lng[c] + lnb[c], n1 = (bf2f(vv >> 16) - mu) * rstd * lng[c + 1] + lnb[c + 1];
        *(float2*)(cvs + c) = make_float2(n0, n1);
        const float w00 = wsp[(size_t)g * 128 * 128], bb = bsp[g * 128];
        *(unsigned*)(O + (size_t)row * 1024 + c) = cvt_pk_bf16(bf2f(uu & 0xffffu) * (w00 * n0 + bb), bf2f(uu >> 16) * (w00 * n1 + bb));
    }
}

__device__ __forceinline__ void phase_ln_mat(const Params& p, size_t zoff, size_t stoff, const float* g, const float* bb, int nb) {
    const bf16_t* Z = (const bf16_t*)(p.ws + zoff); const float2* ST = (const float2*)(p.ws + stoff); bf16_t* X = (bf16_t*)(p.ws + OFF_X0);
    int tid_ = threadIdx.x; asm volatile("" : "+v"(tid_));
    const int tid = tid_, wid = tid >> 6, lane = tid & 63, bi = (int)gridDim.x - 1 - (int)blockIdx.x;
    if (bi >= nb) return;
    const int c0 = lane * 8;
    const f32x4 g0 = *(const f32x4*)(g + c0), g1 = *(const f32x4*)(g + c0 + 4), g2 = *(const f32x4*)(g + 512 + c0), g3 = *(const f32x4*)(g + 512 + c0 + 4);
    const f32x4 b0 = *(const f32x4*)(bb + c0), b1 = *(const f32x4*)(bb + c0 + 4), b2 = *(const f32x4*)(bb + 512 + c0), b3 = *(const f32x4*)(bb + 512 + c0 + 4);
    for (int row0 = (bi * 8 + wid) * 2; row0 < MT; row0 += nb * 16) {
        float2 pr[2]; uint4 za[2], zb[2];
#pragma unroll
        for (int r = 0; r < 2; ++r) { const int row = row0 + r;
            pr[r] = ST[(size_t)row * 16 + (lane & 15)]; za[r] = *(const uint4*)(Z + (size_t)row * 1024 + c0); zb[r] = *(const uint4*)(Z + (size_t)row * 1024 + 512 + c0); }
#pragma unroll
        for (int r = 0; r < 2; ++r) { const int row = row0 + r;
            float s = pr[r].x, q = pr[r].y;
#pragma unroll
            for (int o = 1; o < 16; o <<= 1) { s += __shfl_xor(s, o); q += __shfl_xor(q, o); }
            float mu, rstd; stat_finish(s, q, mu, rstd);
            const f32x4 z0 = (f32x4){bf2f(za[r].x & 0xffffu), bf2f(za[r].x >> 16), bf2f(za[r].y & 0xffffu), bf2f(za[r].y >> 16)}, z1 = (f32x4){bf2f(za[r].z & 0xffffu), bf2f(za[r].z >> 16), bf2f(za[r].w & 0xffffu), bf2f(za[r].w >> 16)};
            const f32x4 z2 = (f32x4){bf2f(zb[r].x & 0xffffu), bf2f(zb[r].x >> 16), bf2f(zb[r].y & 0xffffu), bf2f(zb[r].y >> 16)}, z3 = (f32x4){bf2f(zb[r].z & 0xffffu), bf2f(zb[r].z >> 16), bf2f(zb[r].w & 0xffffu), bf2f(zb[r].w >> 16)};
            const f32x4 x0 = (z0 - mu) * rstd * g0 + b0, x1 = (z1 - mu) * rstd * g1 + b1, x2 = (z2 - mu) * rstd * g2 + b2, x3 = (z3 - mu) * rstd * g3 + b3;
            uint4 w0, w1; w0.x = cvt_pk_bf16(x0[0], x0[1]); w0.y = cvt_pk_bf16(x0[2], x0[3]); w0.z = cvt_pk_bf16(x1[0], x1[1]); w0.w = cvt_pk_bf16(x1[2], x1[3]);
            w1.x = cvt_pk_bf16(x2[0], x2[1]); w1.y = cvt_pk_bf16(x2[2], x2[3]); w1.z = cvt_pk_bf16(x3[0], x3[1]); w1.w = cvt_pk_bf16(x3[2], x3[3]);
            *(uint4*)(X + (size_t)row * 1024 + c0) = w0; *(uint4*)(X + (size_t)row * 1024 + 512 + c0) = w1;
        }
    }
}

__device__ __forceinline__ void phase_final(const Params& p) {
    const bf16_t* Z = (const bf16_t*)(p.ws + OFF_ZFFN); const float2* STF = (const float2*)(p.ws + OFF_STF);
    const float* g = p.in[5] + 3 * 1024; const float* bb = p.in[6] + 3 * 1024;
    int tid_ = threadIdx.x; asm volatile("" : "+v"(tid_));
    const int tid = tid_, wid = tid >> 6, lane = tid & 63, c0 = lane * 8;
    const f32x4 g0 = *(const f32x4*)(g + c0), g1 = *(const f32x4*)(g + c0 + 4), g2 = *(const f32x4*)(g + 512 + c0), g3 = *(const f32x4*)(g + 512 + c0 + 4);
    const f32x4 b0 = *(const f32x4*)(bb + c0), b1 = *(const f32x4*)(bb + c0 + 4), b2 = *(const f32x4*)(bb + 512 + c0), b3 = *(const f32x4*)(bb + 512 + c0 + 4);
    for (int row0 = (blockIdx.x * 8 + wid) * 2; row0 < MT; row0 += gridDim.x * 16) {
        float2 pr[2]; uint4 za[2], zb[2];
#pragma unroll
        for (int r = 0; r < 2; ++r) { const int row = row0 + r;
            pr[r] = STF[(size_t)row * 16 + (lane & 15)]; za[r] = *(const uint4*)(Z + (size_t)row * 1024 + c0); zb[r] = *(const uint4*)(Z + (size_t)row * 1024 + 512 + c0); }
#pragma unroll
        for (int r = 0; r < 2; ++r) { const int row = row0 + r;
            float s = pr[r].x, q = pr[r].y;
#pragma unroll
            for (int o = 1; o < 16; o <<= 1) { s += __shfl_xor(s, o); q += __shfl_xor(q, o); }
            float mu, rstd; stat_finish(s, q, mu, rstd);
            const f32x4 z0 = (f32x4){bf2f(za[r].x & 0xffffu), bf2f(za[r].x >> 16), bf2f(za[r].y & 0xffffu), bf2f(za[r].y >> 16)}, z1 = (f32x4){bf2f(za[r].z & 0xffffu), bf2f(za[r].z >> 16), bf2f(za[r].w & 0xffffu), bf2f(za[r].w >> 16)};
            const f32x4 z2 = (f32x4){bf2f(zb[r].x & 0xffffu), bf2f(zb[r].x >> 16), bf2f(zb[r].y & 0xffffu), bf2f(zb[r].y >> 16)}, z3 = (f32x4){bf2f(zb[r].z & 0xffffu), bf2f(zb[r].z >> 16), bf2f(zb[r].w & 0xffffu), bf2f(zb[r].w >> 16)};
            float* o = p.out + (size_t)row * 1024 + c0;
            *(f32x4*)o = (z0 - mu) * rstd * g0 + b0; *(f32x4*)(o + 4) = (z1 - mu) * rstd * g1 + b1;
            *(f32x4*)(o + 512) = (z2 - mu) * rstd * g2 + b2; *(f32x4*)(o + 516) = (z3 - mu) * rstd * g3 + b3;
        }
    }
}

#define XB_TMO      128
#define XB_XCNT(j)  (256  + 64 * (j))
#define XB_XSUB(j)  (1280 + 64 * (j))
#define XB_XGEN(j)  (2304 + 64 * (j))
#define XB_TOP      3328
#define XB_TOPGEN   3392
#define XCD_BAR_WORDS 3456
#define XB_SPIN_CAP (1u << 18)

__device__ __forceinline__ unsigned xb_ld(unsigned* p)              { return __hip_atomic_load(p, __ATOMIC_RELAXED, __HIP_MEMORY_SCOPE_AGENT); }
__device__ __forceinline__ unsigned xb_add(unsigned* p, unsigned v) { return __hip_atomic_fetch_add(p, v, __ATOMIC_RELAXED, __HIP_MEMORY_SCOPE_AGENT); }
__device__ __forceinline__ unsigned xb_xcc_id() { return (unsigned)__builtin_amdgcn_s_getreg((3 << 11) | 20) & 0xFu; }
#define XB_SPIN(cond, bar) do { unsigned _sp = 0; while (cond) { __builtin_amdgcn_s_sleep(1); \
    if ((++_sp & 255u) == 0u) { if (xb_ld(&(bar)[XB_TMO])) break; if (_sp > XB_SPIN_CAP) { atomicAdd(&(bar)[XB_TMO], 1u); break; } } } } while (0)

struct XcdBarrier {
    unsigned* bar; unsigned x;
    volatile PG8_LAS unsigned* st;
};

__device__ __forceinline__ XcdBarrier xcd_barrier_post(unsigned* bar, volatile PG8_LAS unsigned* st) {
    XcdBarrier b; b.bar = bar; b.x = xb_xcc_id(); b.st = st;
    if (threadIdx.x == 0) (void)xb_add(&bar[XB_XCNT(b.x)], 1u);
    return b;
}
__device__ __forceinline__ void xcd_barrier_complete(unsigned* bar, unsigned x, unsigned& nloc, unsigned& nx) {
    const unsigned G = gridDim.x * gridDim.y * gridDim.z;
    unsigned sum, cnt, mine, sp = 0u;
    for (;;) {
        sum = 0u; cnt = 0u; mine = 0u;
#pragma unroll
        for (unsigned j = 0; j < 16; ++j) { const unsigned c = xb_ld(&bar[XB_XCNT(j)]); sum += c; cnt += (c > 0u) ? 1u : 0u; mine = (j == x) ? c : mine; }
        if (sum == G) break;
        __builtin_amdgcn_s_sleep(1);
        if ((++sp & 255u) == 0u) { if (xb_ld(&bar[XB_TMO])) break; if (sp > XB_SPIN_CAP) { atomicAdd(&bar[XB_TMO], 1u); break; } }
    }
    nloc = mine > 0u ? mine : 1u; nx = cnt > 0u ? cnt : 1u;
}

__device__ __forceinline__ void xcd_barrier(const XcdBarrier& b) {
    asm volatile("s_waitcnt vmcnt(0)" ::: "memory");
    __syncthreads();
    if (threadIdx.x == 0) {
        unsigned* bar = b.bar;
        __builtin_amdgcn_s_waitcnt(0);
        unsigned nloc = b.st[0], nx = b.st[1];
        if (nloc == 0u) { xcd_barrier_complete(bar, b.x, nloc, nx); b.st[0] = nloc; b.st[1] = nx; }
        const unsigned old = xb_add(&bar[XB_XSUB(b.x)], 1u);
        const unsigned gen = old / nloc;
        if (old + 1u == (gen + 1u) * nloc) {
            __builtin_amdgcn_fence(__ATOMIC_RELEASE, "agent");
            asm volatile("s_waitcnt vmcnt(0)" ::: "memory");
            const unsigned og = xb_add(&bar[XB_TOP], 1u);
            const unsigned tg = og / nx;
            if (og + 1u == (tg + 1u) * nx) xb_add(&bar[XB_TOPGEN], 1u);
            else XB_SPIN(xb_ld(&bar[XB_TOPGEN]) == tg, bar);
            __builtin_amdgcn_fence(__ATOMIC_ACQUIRE, "agent");
            xb_add(&bar[XB_XGEN(b.x)], 1u);
            asm volatile("s_waitcnt vmcnt(0)" ::: "memory");
        } else {
            XB_SPIN(xb_ld(&bar[XB_XGEN(b.x)]) == gen, bar);
            __builtin_amdgcn_fence(__ATOMIC_ACQUIRE, "agent");
            asm volatile("s_waitcnt vmcnt(0)" ::: "memory");
        }
    }
    __syncthreads();
}

__global__ void __launch_bounds__(512, 2) hgrn2_chunkmlp_mega(Params p) {
    extern __shared__ __attribute__((aligned(16))) unsigned char shm[];
    cg::grid_group grid = cg::this_grid();
#define WSL(name) unsigned char* name = p.ws; asm volatile("" : "+s"(name))
    unsigned* xb_st = (unsigned*)(shm + 131072);
    if (threadIdx.x < 2) xb_st[threadIdx.x] = 0u;
    if (p.out == nullptr) grid.sync();
    const XcdBarrier xbar = xcd_barrier_post((unsigned*)(p.ws + OFF_BAR), (volatile PG8_LAS unsigned*)xb_st);
    phase_prep(p, shm);
    xcd_barrier(xbar);
#define GRID_SYNC() xcd_barrier(xbar)
#pragma nounroll
    for (int l = 0; l < 4; ++l) {
        const int j = l >> 1;
        if ((l & 1) == 0) {
            WSL(ws);
            pg8::Gemm g; g.A = (const bf16_t*)(ws + (l == 0 ? OFF_X0 : OFF_ZFFN)); g.Bt = (const bf16_t*)(ws + OFF_WT_A_IN) + (size_t)j * 4096 * 1024; g.M = P; g.N = 4096; g.K = 1024;
            Epi e{}; e.stat = l == 0 ? nullptr : (const float2*)(ws + OFF_STF); e.a = (const float*)(ws + OFF_C1_A) + j * 4096; e.b = (const float*)(ws + OFF_C2_A) + j * 4096;
            e.o = (bf16_t*)(ws + OFF_Q); e.x = (const float*)(ws + OFF_LB) + j * 1024;
            run_gemm<0>(shm, g, e);
            GRID_SYNC();
            phase_hgrn_pre(p, shm);
            GRID_SYNC();
            phase_hgrn_prompt(p, shm, j);
            phase_hgrn_sample(p, shm, j);
            GRID_SYNC();
            phase_rms(p, j);
            GRID_SYNC();
        } else {
            WSL(ws);
            pg8::Gemm g; g.A = (const bf16_t*)(ws + OFF_ZFFN); g.Bt = (const bf16_t*)(ws + OFF_WT_B_IN) + (size_t)j * 2048 * 1024; g.M = P; g.N = 2048; g.K = 1024;
            Epi e{}; e.stat = (const float2*)(ws + OFF_STF); e.a = (const float*)(ws + OFF_C1_B) + j * 2048; e.b = (const float*)(ws + OFF_C2_B) + j * 2048;
            e.o = (bf16_t*)(ws + OFF_Q); e.opart = (float2*)(ws + OFF_STV);
            run_gemm<3>(shm, g, e);
            GRID_SYNC();
            phase_spatial(p, shm, j);
            GRID_SYNC();
        }
#pragma nounroll
        for (int r = 0; r < 2; ++r) {
            if (r == 1) {
                WSL(ws);
                pg8::Gemm g; g.A = (const bf16_t*)(ws + OFF_ZMIX); g.Bt = (const bf16_t*)(ws + OFF_WT_F_IN) + (size_t)l * 5632 * 1024; g.M = P; g.N = 5632; g.K = 1024;
                Epi e{}; e.stat = (const float2*)(ws + OFF_STM); e.a = (const float*)(ws + OFF_C1_F) + l * 5632; e.b = (const float*)(ws + OFF_C2_F) + l * 5632; e.o = (bf16_t*)(ws + OFF_H);
                run_gemm<2>(shm, g, e);
                GRID_SYNC();
            }
            WSL(ws);
            pg8::Gemm g; Epi e{}; g.M = P; g.N = 1024;
            if (r == 0) {
                g.A = (const bf16_t*)(ws + OFF_O); g.Bt = (const bf16_t*)(ws + ((l & 1) ? OFF_WT_B_OUT : OFF_WT_A_OUT)) + (size_t)j * 1024 * 1024; g.K = 1024;
                if (l == 0) { e.x = ws + OFF_X0; e.a = (const float*)(ws + OFF_ONES); e.b = (const float*)(ws + OFF_ONES) + 1024; }
                else { e.x = ws + OFF_ZFFN; e.stat = (const float2*)(ws + OFF_STF); e.a = p.in[5] + (l - 1) * 1024; e.b = p.in[6] + (l - 1) * 1024; }
                e.o = (bf16_t*)(ws + OFF_ZMIX); e.opart = (float2*)(ws + OFF_STM);
            } else {
                g.A = (const bf16_t*)(ws + OFF_H); g.Bt = (const bf16_t*)(ws + OFF_WT_F_OUT) + (size_t)l * 1024 * 2816; g.K = 2816;
                e.x = ws + OFF_ZMIX; e.stat = (const float2*)(ws + OFF_STM); e.a = p.in[3] + l * 1024; e.b = p.in[4] + l * 1024;
                e.o = (bf16_t*)(ws + OFF_ZFFN); e.opart = (float2*)(ws + OFF_STF);
            }
            run_gemm<1>(shm, g, e);
            GRID_SYNC();
        }
    }
    phase_final(p);
}

extern "C" void kernel_launch(void* const* d_in, const int* in_sizes, int n_in, void* d_out, int out_size, void* d_ws, size_t ws_size, hipStream_t stream) {
    static int grid = 0;
    if (grid == 0) {
        if (n_in != 19 || ws_size < WS_END) { fprintf(stderr, "kernel_launch: need 19 inputs and %zu bytes of workspace (got %d, %zu)\n", (size_t)WS_END, n_in, ws_size); grid = -1; return; }
        int dev = 0, cus = 0, per_cu = 0;
        hipGetDevice(&dev); hipDeviceGetAttribute(&cus, hipDeviceAttributeMultiprocessorCount, dev);
        if (hipFuncSetAttribute((const void*)hgrn2_chunkmlp_mega, hipFuncAttributeMaxDynamicSharedMemorySize, LDS_BYTES) != hipSuccess) { fprintf(stderr, "kernel_launch: hipFuncSetAttribute failed\n"); grid = -1; return; }
        if (hipOccupancyMaxActiveBlocksPerMultiprocessor(&per_cu, (const void*)hgrn2_chunkmlp_mega, 512, LDS_BYTES) != hipSuccess || per_cu < 1) { fprintf(stderr, "kernel_launch: occupancy query says %d blocks per CU\n", per_cu); grid = -1; return; }
        grid = cus;
        if (grid != 256) { fprintf(stderr, "kernel_launch: built for a 256-CU device (got %d CUs)\n", cus); grid = -1; return; }
    }
    if (grid < 0) return;
    Params p{};
    for (int i = 0; i < 19; ++i) p.in[i] = (const float*)d_in[i];
    p.out = (float*)d_out; p.ws = (unsigned char*)d_ws;
    void* args[] = {&p};
    if (hipMemsetAsync((char*)d_ws + OFF_BAR, 0, 16384, stream) != hipSuccess) { fprintf(stderr, "kernel_launch: hipMemsetAsync of the barrier words failed\n"); return; }
    hipError_t e = hipLaunchCooperativeKernel((void*)hgrn2_chunkmlp_mega, dim3(grid), dim3(512), args, LDS_BYTES, stream);
    if (e != hipSuccess) fprintf(stderr, "cooperative launch failed: %s (grid %d)\n", hipGetErrorString(e), grid);
}
```
